# Optimizing an MI355X kernel written in HIP

```python
import jax, jax.numpy as jnp
from jax import lax
import numpy as np

D_MODEL = 1024
BATCH = 4
SEQ = 8192
DEPTH = 2

MEM_LEN = 256
EPS = 1e-6
MIX_WIDTH = D_MODEL
ML_HEADS = 4
ML_WIDTH = MIX_WIDTH // 2
ML_HD = ML_WIDTH // ML_HEADS
ML_CHUNK = 64
RG_WIDTH = MIX_WIDTH - ML_WIDTH
RG_BLOCKS = 4
RG_BW = RG_WIDTH // RG_BLOCKS
RG_CONV = 4
RG_C = 8.0
IN_COLS = 4 * ML_WIDTH + 2 * ML_HEADS + 2 * RG_WIDTH
SW_HEADS = 16
SW_KV_HEADS = 4
SW_HD = D_MODEL // SW_HEADS
SW_GROUP = SW_HEADS // SW_KV_HEADS
SW_WINDOW = 128
SW_BLOCK = 128
QKV_COLS = (SW_HEADS + 2 * SW_KV_HEADS) * SW_HD
ROPE_THETA = 10000.0
X_HEADS = 4
X_HD = D_MODEL // X_HEADS
D_FF = 4 * D_MODEL
N_EVEN = (DEPTH + 1) // 2
N_ODD = DEPTH // 2

kernel_name = 'hybrid_mlstm_rglru_swa_sink_block'


def rms_norm(x, g):
    xf = x.astype(jnp.float32)
    y = xf * lax.rsqrt(jnp.mean(xf * xf, axis=-1, keepdims=True) + EPS)
    return (y * g.astype(jnp.float32)).astype(x.dtype)


def rotary(t, positions):
    d = t.shape[-1]
    half = d // 2
    inv = jnp.power(ROPE_THETA, -jnp.arange(half, dtype=jnp.float32) * 2.0 / d)
    ang = positions.astype(jnp.float32)[..., None] * inv
    cos = jnp.cos(ang)[:, :, None, :]
    sin = jnp.sin(ang)[:, :, None, :]
    t1 = t[..., :half].astype(jnp.float32)
    t2 = t[..., half:].astype(jnp.float32)
    return jnp.concatenate([t1 * cos - t2 * sin, t2 * cos + t1 * sin], axis=-1).astype(t.dtype)


def mlstm_chunkwise(q, k, v, i_pre, f_pre):
    B, S, H, dh = q.shape
    nc = S // ML_CHUNK
    f32 = jnp.float32

    def to_chunks(t):
        t = t.astype(f32).reshape((B, nc, ML_CHUNK) + t.shape[2:])
        return jnp.moveaxis(t, (1, 3), (0, 2))

    qc = to_chunks(q)
    kc = to_chunks(k) * (dh ** -0.5)
    vc = to_chunks(v)
    logi = to_chunks(i_pre)
    logf = to_chunks(jax.nn.log_sigmoid(f_pre.astype(f32)))
    causal = jnp.tril(jnp.ones((ML_CHUNK, ML_CHUNK), dtype=bool))

    def step(carry, inp):
        C, n, m = carry
        qb, kb, vb, li, lf = inp
        b = jnp.cumsum(lf, axis=-1)
        dmat = b[..., :, None] - b[..., None, :] + li[..., None, :]
        dmat = jnp.where(causal, dmat, -jnp.inf)
        m_t = jnp.maximum(b + m[..., None], jnp.max(dmat, axis=-1))
        decay_prev = jnp.exp(b + m[..., None] - m_t)
        s = jnp.einsum('bhtd,bhsd->bhts', qb, kb) * jnp.exp(dmat - m_t[..., None])
        num = jnp.einsum('bhts,bhsd->bhtd', s, vb) + decay_prev[..., None] * jnp.einsum('bhtd,bhde->bhte', qb, C)
        den = jnp.sum(s, axis=-1) + decay_prev * jnp.einsum('bhtd,bhd->bht', qb, n)
        h = num / jnp.maximum(jnp.abs(den), jnp.exp(-m_t))[..., None]
        b_last = b[..., -1]
        g = b_last[..., None] - b + li
        m_new = jnp.maximum(b_last + m, jnp.max(g, axis=-1))
        w_prev = jnp.exp(b_last + m - m_new)
        w_s = jnp.exp(g - m_new[..., None])
        C_new = w_prev[..., None, None] * C + jnp.einsum('bhs,bhsd,bhse->bhde', w_s, kb, vb)
        n_new = w_prev[..., None] * n + jnp.einsum('bhs,bhsd->bhd', w_s, kb)
        return (C_new, n_new, m_new), h

    init = (jnp.zeros((B, H, dh, dh), f32), jnp.zeros((B, H, dh), f32), jnp.zeros((B, H), f32))
    _, hs = lax.scan(step, init, (qc, kc, vc, logi, logf))
    hs = jnp.moveaxis(hs, (0, 2), (1, 3))
    return hs.reshape(B, S, H * dh)


def rg_lru_branch(rx, conv_w, conv_b, rg_wa, rg_ba, rg_wx, rg_bx, rg_lambda):
    B, S, _ = rx.shape
    xc = lax.conv_general_dilated(rx, conv_w[:, None, :], window_strides=(1,),
                                  padding=[(RG_CONV - 1, 0)],
                                  dimension_numbers=('NWC', 'WIO', 'NWC'),
                                  feature_group_count=RG_WIDTH) + conv_b
    xb = xc.reshape(B, S, RG_BLOCKS, RG_BW)
    r = jax.nn.sigmoid((jnp.einsum('bsnc,ncd->bsnd', xb, rg_wa).reshape(B, S, RG_WIDTH) + rg_ba).astype(jnp.float32))
    i = jax.nn.sigmoid((jnp.einsum('bsnc,ncd->bsnd', xb, rg_wx).reshape(B, S, RG_WIDTH) + rg_bx).astype(jnp.float32))
    log_a = -RG_C * r * jax.nn.softplus(-rg_lambda.astype(jnp.float32))
    a = jnp.exp(log_a)
    u = jnp.sqrt(-jnp.expm1(2.0 * log_a)) * (i * xc.astype(jnp.float32))

    def combine(e1, e2):
        a1, b1 = e1
        a2, b2 = e2
        return a1 * a2, a2 * b1 + b2

    _, h = lax.associative_scan(combine, (a, u), axis=1)
    return h


def mlstm_rglru_mixer(u, w_in, b_if, conv_w, conv_b, rg_wa, rg_ba, rg_wx, rg_bx, rg_lambda, w_out):
    B, S, _ = u.shape
    z = u @ w_in
    q, k, v, o, gif, rx, ry = jnp.split(z, [ML_WIDTH, 2 * ML_WIDTH, 3 * ML_WIDTH, 4 * ML_WIDTH,
                                            4 * ML_WIDTH + 2 * ML_HEADS,
                                            4 * ML_WIDTH + 2 * ML_HEADS + RG_WIDTH], axis=-1)
    gif = gif + b_if
    i_pre, f_pre = gif[..., :ML_HEADS], gif[..., ML_HEADS:]
    hm = mlstm_chunkwise(q.reshape(B, S, ML_HEADS, ML_HD), k.reshape(B, S, ML_HEADS, ML_HD),
                         v.reshape(B, S, ML_HEADS, ML_HD), i_pre, f_pre)
    y_a = jax.nn.sigmoid(o) * hm.astype(u.dtype)
    h_rg = rg_lru_branch(rx, conv_w, conv_b, rg_wa, rg_ba, rg_wx, rg_bx, rg_lambda)
    y_b = jax.nn.gelu(ry) * h_rg.astype(u.dtype)
    return jnp.concatenate([y_a, y_b], axis=-1) @ w_out


def sliding_window_sink_attention(u, positions, w_qkv, sinks, w_o):
    B, S, _ = u.shape
    qkv = u @ w_qkv
    q, k, v = jnp.split(qkv, [SW_HEADS * SW_HD, (SW_HEADS + SW_KV_HEADS) * SW_HD], axis=-1)
    q = rotary(q.reshape(B, S, SW_HEADS, SW_HD), positions).reshape(B, S, SW_KV_HEADS, SW_GROUP, SW_HD)
    k = rotary(k.reshape(B, S, SW_KV_HEADS, SW_HD), positions)
    v = v.reshape(B, S, SW_KV_HEADS, SW_HD)
    pad = ((0, 0), (SW_BLOCK, 0), (0, 0), (0, 0))
    kp = jnp.pad(k, pad)
    vp = jnp.pad(v, pad)
    nb = S // SW_BLOCK
    r = jnp.arange(SW_BLOCK)[:, None]
    c = jnp.arange(2 * SW_BLOCK)[None, :]
    diff = r + SW_BLOCK - c
    band = (diff >= 0) & (diff < SW_WINDOW)
    sink = sinks.astype(jnp.float32).reshape(SW_KV_HEADS, SW_GROUP)[None, :, :, None]
    scale = SW_HD ** -0.5

    def block(j):
        start = j * SW_BLOCK
        qb = lax.dynamic_slice_in_dim(q, start, SW_BLOCK, axis=1)
        kb = lax.dynamic_slice_in_dim(kp, start, 2 * SW_BLOCK, axis=1)
        vb = lax.dynamic_slice_in_dim(vp, start, 2 * SW_BLOCK, axis=1)
        s = jnp.einsum('blkgd,bckd->bkglc', qb, kb).astype(jnp.float32) * scale
        valid = band & (start + c - SW_BLOCK >= 0)
        s = jnp.where(valid, s, -jnp.inf)
        m = jnp.maximum(jnp.max(s, axis=-1), sink)
        p = jnp.exp(s - m[..., None])
        den = jnp.sum(p, axis=-1) + jnp.exp(sink - m)
        ob = jnp.einsum('bkglc,bckd->blkgd', p, vb.astype(jnp.float32))
        ob = ob / jnp.moveaxis(den, -1, 1)[..., None]
        return ob.astype(u.dtype)

    out = lax.map(block, jnp.arange(nb))
    out = jnp.moveaxis(out, 0, 1).reshape(B, S, SW_HEADS * SW_HD)
    return out @ w_o


def memory_cross_attention(u, mem, g_mem, w_q, w_kv, w_o):
    B, S, _ = u.shape
    M = mem.shape[1]
    q = (u @ w_q).reshape(B, S, X_HEADS, X_HD)
    kv = (rms_norm(mem, g_mem) @ w_kv).reshape(B, M, 2, X_HEADS, X_HD)
    k, v = kv[:, :, 0], kv[:, :, 1]
    s = jnp.einsum('bshd,bmhd->bhsm', q, k).astype(jnp.float32) * (X_HD ** -0.5)
    p = jax.nn.softmax(s, axis=-1)
    o = jnp.einsum('bhsm,bmhd->bshd', p.astype(v.dtype), v).reshape(B, S, D_MODEL)
    return o @ w_o


def squared_relu_mlp(u, w1, w2):
    return jnp.square(jax.nn.relu(u @ w1)) @ w2


def setup_inputs(seed: int = 0) -> dict:
    key = jax.random.key(seed)
    ks = iter(jax.random.split(key, 40))

    def nrm(shape, scale):
        return jax.random.normal(next(ks), shape, jnp.float32) * scale

    def gains(n):
        return 1.0 + nrm((n, D_MODEL), 0.02)

    x = nrm((BATCH, SEQ, D_MODEL), 1.0)
    mem = nrm((BATCH, MEM_LEN, D_MODEL), 1.0)
    positions = jnp.broadcast_to(jnp.arange(SEQ, dtype=jnp.int32)[None, :], (BATCH, SEQ))
    ev_w_in = nrm((N_EVEN, D_MODEL, IN_COLS), D_MODEL ** -0.5)
    ev_b_if = jnp.concatenate([nrm((N_EVEN, ML_HEADS), 0.1),
                               jnp.linspace(3.0, 6.0, ML_HEADS)[None, :] + nrm((N_EVEN, ML_HEADS), 0.01)], axis=-1)
    ev_conv_w = nrm((N_EVEN, RG_CONV, RG_WIDTH), RG_CONV ** -0.5)
    ev_conv_b = nrm((N_EVEN, RG_WIDTH), 0.01)
    ev_rg_wa = nrm((N_EVEN, RG_BLOCKS, RG_BW, RG_BW), RG_BW ** -0.5)
    ev_rg_ba = nrm((N_EVEN, RG_WIDTH), 0.01)
    ev_rg_wx = nrm((N_EVEN, RG_BLOCKS, RG_BW, RG_BW), RG_BW ** -0.5)
    ev_rg_bx = nrm((N_EVEN, RG_WIDTH), 0.01)
    a_c = jax.random.uniform(next(ks), (N_EVEN, RG_WIDTH), jnp.float32, 0.9, 0.999)
    a_base = a_c ** (1.0 / RG_C)
    ev_rg_lambda = jnp.log(a_base) - jnp.log1p(-a_base)
    ev_w_out = nrm((N_EVEN, MIX_WIDTH, D_MODEL), MIX_WIDTH ** -0.5)
    od_w_qkv = nrm((N_ODD, D_MODEL, QKV_COLS), D_MODEL ** -0.5)
    od_sinks = nrm((N_ODD, SW_HEADS), 1.0)
    od_w_o = nrm((N_ODD, SW_HEADS * SW_HD, D_MODEL), (SW_HEADS * SW_HD) ** -0.5)
    return {
        'x': x, 'mem': mem, 'positions': positions,
        'ev_w_in': ev_w_in, 'ev_b_if': ev_b_if, 'ev_conv_w': ev_conv_w, 'ev_conv_b': ev_conv_b,
        'ev_rg_wa': ev_rg_wa, 'ev_rg_ba': ev_rg_ba, 'ev_rg_wx': ev_rg_wx, 'ev_rg_bx': ev_rg_bx,
        'ev_rg_lambda': ev_rg_lambda, 'ev_w_out': ev_w_out,
        'od_w_qkv': od_w_qkv, 'od_sinks': od_sinks, 'od_w_o': od_w_o,
        'g_mix_pre': gains(DEPTH), 'g_mix_post': gains(DEPTH),
        'g_x_pre': gains(DEPTH), 'g_x_post': gains(DEPTH), 'g_mem': gains(DEPTH),
        'w_xq': nrm((DEPTH, D_MODEL, D_MODEL), D_MODEL ** -0.5),
        'w_xkv': nrm((DEPTH, D_MODEL, 2 * D_MODEL), D_MODEL ** -0.5),
        'w_xo': nrm((DEPTH, D_MODEL, D_MODEL), D_MODEL ** -0.5),
        'g_ff_pre': gains(DEPTH), 'g_ff_post': gains(DEPTH),
        'w_ff1': nrm((DEPTH, D_MODEL, D_FF), D_MODEL ** -0.5),
        'w_ff2': nrm((DEPTH, D_FF, D_MODEL), D_FF ** -0.5),
    }


def reference(x, mem, positions, ev_w_in, ev_b_if, ev_conv_w, ev_conv_b, ev_rg_wa, ev_rg_ba,
              ev_rg_wx, ev_rg_bx, ev_rg_lambda, ev_w_out, od_w_qkv, od_sinks, od_w_o,
              g_mix_pre, g_mix_post, g_x_pre, g_x_post, g_mem, w_xq, w_xkv, w_xo,
              g_ff_pre, g_ff_post, w_ff1, w_ff2):
    h = x
    for l in range(DEPTH):
        u = rms_norm(h, g_mix_pre[l])
        if l % 2 == 0:
            e = l // 2
            u = mlstm_rglru_mixer(u, ev_w_in[e], ev_b_if[e], ev_conv_w[e], ev_conv_b[e],
                                  ev_rg_wa[e], ev_rg_ba[e], ev_rg_wx[e], ev_rg_bx[e],
                                  ev_rg_lambda[e], ev_w_out[e])
        else:
            o = l // 2
            u = sliding_window_sink_attention(u, positions, od_w_qkv[o], od_sinks[o], od_w_o[o])
        h = h + rms_norm(u, g_mix_post[l])
        u = memory_cross_attention(rms_norm(h, g_x_pre[l]), mem, g_mem[l], w_xq[l], w_xkv[l], w_xo[l])
        h = h + rms_norm(u, g_x_post[l])
        u = squared_relu_mlp(rms_norm(h, g_ff_pre[l]), w_ff1[l], w_ff2[l])
        h = h + rms_norm(u, g_ff_post[l])
    return h
```

```cpp
#include <hip/hip_runtime.h>
#include <cstdio>
#include <cstdint>
#include <cmath>
namespace pg8 {
#define PG8_LAS __attribute__((address_space(3)))
typedef unsigned short bf16_t;
typedef short bf16x8 __attribute__((ext_vector_type(8)));
typedef float f32x4 __attribute__((ext_vector_type(4)));
typedef unsigned u32x4 __attribute__((ext_vector_type(4)));
constexpr int BM = 256, BK = 64, HALF = 128, HTB = HALF * BK * 2  , STAGE_BYTES = 8 * HTB, NXCD = 8, WGM = 8;

__host__ __device__ __forceinline__ int lds_byte(int r, int c) { const int st = (r >> 4) * 2 + (c >> 5), rr = r & 15, cc = c & 31, ob = rr * 64 + cc * 2; return st * 1024 + (ob ^ (((ob >> 9) & 1) << 5)); }
__host__ __device__ __forceinline__ void stage_rc(int b, int& R, int& C) { const int st = b / 1024, sb = b % 1024, swz = sb ^ (((sb >> 9) & 1) << 5); R = (st >> 1) * 16 + swz / 64; C = (st & 1) * 32 + (swz % 64) / 2; }
__host__ __device__ __forceinline__ int perm32(int rho) { const int n = rho >> 4, i = rho & 15; return 8 * (i >> 2) + 4 * n + (i & 3); }

struct Unit { int pm, pn; };
struct Gemm { const bf16_t* A; const bf16_t* Bt; int M, N, K; int lda, ldb; };

struct StaticOrder {
    int nM, nN, nwg, G, c;
    __host__ __device__ void init(int M, int N, int G_, int c_) { nM = M / BM; nN = N / BM; nwg = nM * nN; G = G_; c = c_; }
    __host__ __device__ bool next(int i, Unit& u) const {
        const long L = (long)i * G + c; if (L >= nwg) return false;
        int wgid = (int)L; { const int q = nwg / NXCD, r = nwg % NXCD, xcd = wgid % NXCD, off = wgid / NXCD; wgid = (xcd < r ? xcd * (q + 1) : r * (q + 1) + (xcd - r) * q) + off; }
        const int nig = WGM * nN, gid = wgid / nig, fm = gid * WGM, gsz = (nM - fm) < WGM ? (nM - fm) : WGM;
        u.pm = fm + ((wgid % nig) % gsz); u.pn = (wgid % nig) / gsz; return true;
    }
    __device__ __forceinline__ void a_ready(const Unit&) const {}
    __device__ __forceinline__ void done(const Unit&) const {}
    __device__ __forceinline__ size_t a_off(const Unit& u, size_t ta) const { return (size_t)u.pm * ta; }
    __device__ __forceinline__ size_t b_off(const Unit& u, size_t tb) const { return (size_t)u.pn * tb; }
};

__device__ __forceinline__ unsigned cvt_pk_bf16(float lo, float hi) { unsigned r; asm volatile("v_cvt_pk_bf16_f32 %0, %1, %2" : "=v"(r) : "v"(lo), "v"(hi)); return r; }
typedef float f32x2 __attribute__((ext_vector_type(2)));
__device__ __forceinline__ __amdgpu_buffer_rsrc_t wt_rsrc(const void* base) { return __builtin_amdgcn_make_buffer_rsrc(const_cast<void*>(base), 0, 0x7fffffff, 0x00020000); }
__device__ __forceinline__ void wt_store16(u32x4 v, __amdgpu_buffer_rsrc_t r, size_t byte_off) { __builtin_amdgcn_raw_buffer_store_b128(v, r, (int)(unsigned)byte_off, 0, 16); }
template <int ACT  , bool PF = false  > struct EpiOut {
    static constexpr bool PERM = true, AFTER_DRAIN = false, PREFETCH = PF;
    struct Pre {};
    bf16_t* O; int ldc; float scale; int pnmask; const float* rs; const float* cs; int wt; PG8_LAS float* rsl;
    __device__ __forceinline__ void prefetch(Pre&, const Unit& u, int wr, int wc, int fr, int fq) const {
        if (rs) { PG8_LAS float* slot = rsl + (wr * 4 + wc) * 128; const float* src = rs + u.pm * BM + wr * 64 + fq * 16 + fr;
            __builtin_amdgcn_global_load_lds((const unsigned*)src, (PG8_LAS unsigned*)slot, 4, 0, 0); __builtin_amdgcn_global_load_lds((const unsigned*)(src + HALF), (PG8_LAS unsigned*)(slot + 64), 4, 0, 0); }
    }
    __device__ __forceinline__ void operator()(const f32x4 (&acc)[2][2][4][2], const Unit& u, int wr, int wc, int fr, int fq) const { Pre p; with_pre(acc, p, u, wr, wc, fr, fq); }
    __device__ __forceinline__ void with_pre(const f32x4 (&acc)[2][2][4][2], const Pre&, const Unit& u, int wr, int wc, int fr, int fq) const {
        const int row0 = u.pm * BM + wr * 64 + fr; const int col0 = (u.pn & pnmask) * BM + wc * 32 + 8 * fq;
        const __amdgpu_buffer_rsrc_t wr_ = wt_rsrc(O);
        float r0[4], r1[4];
        if (PF) { const PG8_LAS float* slot = rsl + (wr * 4 + wc) * 128 + fr;
#pragma unroll
            for (int m = 0; m < 4; ++m) { r0[m] = rs ? slot[m * 16] : 1.f; r1[m] = rs ? slot[64 + m * 16] : 1.f; } }
        else {
#pragma unroll
            for (int m = 0; m < 4; ++m) { r0[m] = rs ? rs[row0 + m * 16] : 1.f; r1[m] = rs ? rs[row0 + HALF + m * 16] : 1.f; } }
        f32x4 cv[2][2];
#pragma unroll
        for (int bj = 0; bj < 2; ++bj) { cv[bj][0] = cs ? *(const f32x4*)(cs + col0 + bj * HALF) : (f32x4){1.f, 1.f, 1.f, 1.f}; cv[bj][1] = cs ? *(const f32x4*)(cs + col0 + bj * HALF + 4) : (f32x4){1.f, 1.f, 1.f, 1.f}; }
#pragma unroll
        for (int ai = 0; ai < 2; ++ai)
#pragma unroll
            for (int m = 0; m < 4; ++m) { const int row = row0 + ai * HALF + m * 16; bf16_t* rowp = O + (size_t)row * ldc + col0; const float sc = scale * (ai == 0 ? r0[m] : r1[m]);
#pragma unroll
                for (int bj = 0; bj < 2; ++bj) { f32x4 v0 = acc[ai][bj][m][0] * cv[bj][0], v1 = acc[ai][bj][m][1] * cv[bj][1];
                    if (ACT == 2) {
#pragma unroll
                        for (int e = 0; e < 4; ++e) { const float a = fmaxf(v0[e] * sc, 0.f), b = fmaxf(v1[e] * sc, 0.f); v0[e] = a * a; v1[e] = b * b; } }
                    else { v0 = v0 * sc; v1 = v1 * sc; }
                    u32x4 w; w.x = cvt_pk_bf16(v0[0], v0[1]); w.y = cvt_pk_bf16(v0[2], v0[3]); w.z = cvt_pk_bf16(v1[0], v1[1]); w.w = cvt_pk_bf16(v1[2], v1[3]);
                    if (wt) wt_store16(w, wr_, (size_t)((const char*)(rowp + bj * HALF) - (const char*)O)); else *(u32x4*)(rowp + bj * HALF) = w; } }
    }
};
struct EpiRope {
    static constexpr bool PERM = true, AFTER_DRAIN = false, PREFETCH = false;
    struct Pre {};
    bf16_t* O; int ldc; const float* cs; int qcols; float qscale; const float* rs;
    __device__ __forceinline__ void operator()(const f32x4 (&acc)[2][2][4][2], const Unit& u, int wr, int wc, int fr, int fq) const {
        const int row0 = u.pm * BM + wr * 64 + fr; const int col0 = u.pn * BM + wc * 32 + 8 * fq;
#pragma unroll
        for (int ai = 0; ai < 2; ++ai)
#pragma unroll
            for (int m = 0; m < 4; ++m) { const int row = row0 + ai * HALF + m * 16; bf16_t* rowp = O + (size_t)row * ldc + col0;
#pragma unroll
                for (int bj = 0; bj < 2; ++bj) { const int col = col0 + bj * HALF; const int i0 = (col & 63) >> 1;
                    const f32x4* cp = (const f32x4*)(cs + (size_t)row * 64 + i0 * 2); const f32x4 c01 = cp[0], c23 = cp[1];
                    const f32x4 v0 = acc[ai][bj][m][0], v1 = acc[ai][bj][m][1]; const float sc = (col < qcols ? qscale : 1.f) * rs[row];
                    f32x4 o0, o1;
                    if (col >= 1280) { o0 = v0; o1 = v1; } else {
                    o0[0] = v0[0] * c01[0] - v0[1] * c01[1]; o0[1] = v0[1] * c01[0] + v0[0] * c01[1]; o0[2] = v0[2] * c01[2] - v0[3] * c01[3]; o0[3] = v0[3] * c01[2] + v0[2] * c01[3];
                    o1[0] = v1[0] * c23[0] - v1[1] * c23[1]; o1[1] = v1[1] * c23[0] + v1[0] * c23[1]; o1[2] = v1[2] * c23[2] - v1[3] * c23[3]; o1[3] = v1[3] * c23[2] + v1[2] * c23[3]; }
                    o0 = o0 * sc; o1 = o1 * sc;
                    u32x4 w; w.x = cvt_pk_bf16(o0[0], o0[1]); w.y = cvt_pk_bf16(o0[2], o0[3]); w.z = cvt_pk_bf16(o1[0], o1[1]); w.w = cvt_pk_bf16(o1[2], o1[3]);
                    *(u32x4*)(rowp + bj * HALF) = w; } }
    }
};
struct EpiOutKP {
    static constexpr bool PERM = true, AFTER_DRAIN = false, PREFETCH = false;
    struct Pre {};
    bf16_t* O; int ldc; int pnmask; int pm_from; const float* cs;
    __device__ __forceinline__ void operator()(const f32x4 (&acc)[2][2][4][2], const Unit& u, int wr, int wc, int fr, int fq) const {
        typedef unsigned u32x2 __attribute__((ext_vector_type(2)));
        const int row0 = u.pm * BM + wr * 64 + fr; const int col0 = (u.pn & pnmask) * BM + wc * 32 + 8 * fq; const bool kp = u.pm >= pm_from;
#pragma unroll
        for (int ai = 0; ai < 2; ++ai)
#pragma unroll
            for (int m = 0; m < 4; ++m) { bf16_t* rowp = O + (size_t)(row0 + ai * HALF + m * 16) * ldc;
#pragma unroll
                for (int bj = 0; bj < 2; ++bj) { const int col = col0 + bj * HALF; const f32x4 v0 = acc[ai][bj][m][0] * (cs ? *(const f32x4*)(cs + col) : (f32x4){1.f, 1.f, 1.f, 1.f}), v1 = acc[ai][bj][m][1] * (cs ? *(const f32x4*)(cs + col + 4) : (f32x4){1.f, 1.f, 1.f, 1.f});
                    u32x4 w; w.x = cvt_pk_bf16(v0[0], v0[1]); w.y = cvt_pk_bf16(v0[2], v0[3]); w.z = cvt_pk_bf16(v1[0], v1[1]); w.w = cvt_pk_bf16(v1[2], v1[3]);
                    if (kp) { const int p0 = (col & ~15) + 4 * ((col >> 3) & 1); *(u32x2*)(rowp + p0) = (u32x2){w.x, w.y}; *(u32x2*)(rowp + p0 + 8) = (u32x2){w.z, w.w}; }
                    else *(u32x4*)(rowp + col) = w; } }
    }
};
struct EpiSoftmax {
    static constexpr bool PERM = true, AFTER_DRAIN = false, PREFETCH = false;
    struct Pre {};
    bf16_t* O; int ldc; const float* rs; float qscale_log2e; PG8_LAS float* part;
    __device__ __forceinline__ void operator()(f32x4 (&acc)[2][2][4][2], const Unit& u, int wr, int wc, int fr, int fq) const {
        const int row0 = u.pm * BM + wr * 64 + fr; const int col0 = (u.pn & 3) * BM + wc * 32 + 8 * fq;
        const __amdgpu_buffer_rsrc_t wr_ = wt_rsrc(O);
#pragma unroll
        for (int ai = 0; ai < 2; ++ai)
#pragma unroll
            for (int m = 0; m < 4; ++m) { const float sc = rs[row0 + ai * HALF + m * 16] * qscale_log2e; float ps = 0.f;
#pragma unroll
                for (int bj = 0; bj < 2; ++bj)
#pragma unroll
                    for (int n = 0; n < 2; ++n) { f32x4 v = acc[ai][bj][m][n] * sc;
#pragma unroll
                        for (int e = 0; e < 4; ++e) { v[e] = __builtin_amdgcn_exp2f(fminf(v[e], 80.f)); ps += v[e]; }
                        acc[ai][bj][m][n] = v; }
                ps += __shfl_xor(ps, 16); ps += __shfl_xor(ps, 32);
                if (fq == 0) part[(ai * HALF + wr * 64 + m * 16 + fr) * 4 + wc] = ps; }
        asm volatile("s_waitcnt lgkmcnt(0)" ::: "memory"); __builtin_amdgcn_s_barrier(); asm volatile("" ::: "memory");
#pragma unroll
        for (int ai = 0; ai < 2; ++ai)
#pragma unroll
            for (int m = 0; m < 4; ++m) { const f32x4 p4 = *(const PG8_LAS f32x4*)(part + (ai * HALF + wr * 64 + m * 16 + fr) * 4); const float inv = 1.0f / ((p4[0] + p4[1]) + (p4[2] + p4[3]));
                bf16_t* rowp = O + (size_t)(row0 + ai * HALF + m * 16) * ldc + col0;
#pragma unroll
                for (int bj = 0; bj < 2; ++bj) { const f32x4 v0 = acc[ai][bj][m][0] * inv, v1 = acc[ai][bj][m][1] * inv;
                    u32x4 w; w.x = cvt_pk_bf16(v0[0], v0[1]); w.y = cvt_pk_bf16(v0[2], v0[3]); w.z = cvt_pk_bf16(v1[0], v1[1]); w.w = cvt_pk_bf16(v1[2], v1[3]);
                    wt_store16(w, wr_, (size_t)((const char*)(rowp + bj * HALF) - (const char*)O)); } }
        asm volatile("s_waitcnt lgkmcnt(0)" ::: "memory");
    }
};
struct EpiFold {
    static constexpr bool PERM = true, AFTER_DRAIN = false, PREFETCH = false;
    struct Pre {};
    bf16_t* O;
    __device__ __forceinline__ void operator()(const f32x4 (&acc)[2][2][4][2], const Unit&, int wr, int wc, int fr, int fq) const {
        const int row0 = wr * 64 + fr, col0 = wc * 32 + 8 * fq;
#pragma unroll
        for (int ai = 0; ai < 2; ++ai)
#pragma unroll
            for (int m = 0; m < 4; ++m) { bf16_t* rowp = O + (size_t)(row0 + ai * HALF + m * 16) * 1024 + col0;
#pragma unroll
                for (int bj = 0; bj < 2; ++bj) { const f32x4 v0 = acc[ai][bj][m][0] * 1.0f, v1 = acc[ai][bj][m][1] * 1.0f;
                    u32x4 w; w.x = cvt_pk_bf16(v0[0], v0[1]); w.y = cvt_pk_bf16(v0[2], v0[3]); w.z = cvt_pk_bf16(v1[0], v1[1]); w.w = cvt_pk_bf16(v1[2], v1[3]);
                    *(u32x4*)(rowp + bj * HALF) = w; } }
    }
};
struct DiagOrder {
    int c;
    __device__ __forceinline__ bool next(int i, Unit& u) const { if (i > 0 || c >= 64) return false; const int l = c >> 5, r = c & 31; u.pm = 4 * l + (r >> 3); u.pn = 8 * l + (r & 7); return true; }
    __device__ __forceinline__ void a_ready(const Unit&) const {}
    __device__ __forceinline__ void done(const Unit&) const {}
    __device__ __forceinline__ size_t a_off(const Unit& u, size_t ta) const { return (size_t)u.pm * ta; }
    __device__ __forceinline__ size_t b_off(const Unit& u, size_t tb) const { return (size_t)u.pn * tb; }
};
struct BatchOrder {
    StaticOrder so;
    __device__ __forceinline__ bool next(int i, Unit& u) const { return so.next(i, u); }
    __device__ __forceinline__ void a_ready(const Unit&) const {}
    __device__ __forceinline__ void done(const Unit&) const {}
    __device__ __forceinline__ size_t a_off(const Unit& u, size_t ta) const { return (size_t)u.pm * ta; }
    __device__ __forceinline__ size_t b_off(const Unit& u, size_t tb) const { return (size_t)((u.pm >> 5) * 4 + u.pn) * tb; }
};
struct GroupOrder {
    int g, m, per, batched;
    __device__ __forceinline__ bool next(int i, Unit& u) const { if (i >= 2 * per) return false; const int p = i / per, j = i - p * per; u.pm = 2 * g + p; u.pn = m + 4 * j; return true; }
    __device__ __forceinline__ void a_ready(const Unit&) const {}
    __device__ __forceinline__ void done(const Unit&) const {}
    __device__ __forceinline__ size_t a_off(const Unit& u, size_t ta) const { return (size_t)u.pm * ta; }
    __device__ __forceinline__ size_t b_off(const Unit& u, size_t tb) const { return (size_t)((batched ? (u.pm >> 5) * 4 : 0) + u.pn) * tb; }
};
struct OneUnit {
    __device__ __forceinline__ bool next(int i, Unit& u) const { if (i > 0) return false; u.pm = 0; u.pn = 0; return true; }
    __device__ __forceinline__ void a_ready(const Unit&) const {}
    __device__ __forceinline__ void done(const Unit&) const {}
    __device__ __forceinline__ size_t a_off(const Unit&, size_t) const { return 0; }
    __device__ __forceinline__ size_t b_off(const Unit&, size_t) const { return 0; }
};

template <class Epi, class Sched, bool ALIGN_EPI = false, bool SP2 = false>
__device__ __forceinline__ void gemm_phase(PG8_LAS unsigned char* lds, const Gemm g, const Sched& S, const Epi& E) {
    const int tid = threadIdx.x, wid = __builtin_amdgcn_readfirstlane(tid >> 6), lane = tid & 63, wr = wid >> 2, wc = wid & 3, fr = lane & 15, fq = lane >> 4;
    const int K = g.K, nt = K / BK; const int lda = g.lda ? g.lda : K, ldb = g.ldb ? g.ldb : K;
    unsigned voffA[2], voffB[2];
#pragma unroll
    for (int i = 0; i < 2; ++i) { int R, C; stage_rc(tid * 16 + i * 8192, R, C); const int Rb = Epi::PERM ? ((R & ~31) + perm32(R & 31)) : R;
        voffA[i] = (unsigned)(R * lda + C) * 2u; voffB[i] = (unsigned)(Rb * ldb + C) * 2u; }
    const size_t kstep = (size_t)(BK * 2);
    const size_t hstepA = (size_t)HALF * lda * 2, hstepB = (size_t)HALF * ldb * 2;
    const size_t tstepA = 2 * hstepA, tstepB = 2 * hstepB;
    const unsigned ldsw = (unsigned)wid * 1024u;
    const int aoff = lds_byte(wr * 64 + fr, fq * 8), boff = lds_byte(wc * 32 + fr, fq * 8);
#define PG8_SA(b, h) (((b) * 2 + (h)) * HTB)
#define PG8_SB(b, h) ((4 + (b) * 2 + (h)) * HTB)
#define PG8_STAGE(bufoff, gbase, voff) do { _Pragma("unroll") for (int _i = 0; _i < 2; ++_i) \
        __builtin_amdgcn_global_load_lds((const unsigned*)((const char*)(gbase) + (voff)[_i]), (PG8_LAS unsigned*)(lds + (bufoff) + ldsw + _i * 8192), 16, 0, 0); } while (0)
#define PG8_LDA(dst, b, h) do { _Pragma("unroll") for (int m = 0; m < 4; ++m) _Pragma("unroll") for (int k = 0; k < 2; ++k) dst[m][k] = *(const PG8_LAS bf16x8*)(lds + PG8_SA(b, h) + aoff + m * 2048 + k * 1024); } while (0)
#define PG8_LDB(dst, b, h) do { _Pragma("unroll") for (int n = 0; n < 2; ++n) _Pragma("unroll") for (int k = 0; k < 2; ++k) dst[n][k] = *(const PG8_LAS bf16x8*)(lds + PG8_SB(b, h) + boff + n * 2048 + k * 1024); } while (0)
#define PG8_MMA(ai, bj, At, Bt) do { __builtin_amdgcn_s_setprio(1); _Pragma("unroll") for (int m = 0; m < 4; ++m) _Pragma("unroll") for (int n = 0; n < 2; ++n) _Pragma("unroll") for (int k = 0; k < 2; ++k) \
        acc[ai][bj][m][n] = __builtin_amdgcn_mfma_f32_16x16x32_bf16(Bt[n][k], At[m][k], acc[ai][bj][m][n], 0, 0, 0); __builtin_amdgcn_s_setprio(0); } while (0)
#define PG8_WAIT_V(n) asm volatile("s_waitcnt vmcnt(" #n ")" ::: "memory")
#define PG8_WAIT_L(n) asm volatile("s_waitcnt lgkmcnt(" #n ")" ::: "memory")
#define PG8_BAR __builtin_amdgcn_s_barrier()
#define PG8_SCHED __builtin_amdgcn_sched_barrier(0)
    Unit cur, nxt; int ui = 0;
    if (!S.next(0, cur)) return;
    typename Epi::Pre pre = {};
    f32x4 acc[2][2][4][2];
#pragma unroll
    for (int a = 0; a < 2; ++a)
#pragma unroll
        for (int b = 0; b < 2; ++b)
#pragma unroll
            for (int m = 0; m < 4; ++m)
#pragma unroll
                for (int n = 0; n < 2; ++n) acc[a][b][m][n] = (f32x4){0.f, 0.f, 0.f, 0.f};
    bf16x8 At[4][2], B0[2][2], B1[2][2];
    const char* cA = (const char*)g.A + S.a_off(cur, tstepA); const char* cB = (const char*)g.Bt + S.b_off(cur, tstepB);
    S.a_ready(cur);
    if constexpr (SP2) {
        PG8_STAGE(PG8_SB(0, 0), cB, voffB); PG8_STAGE(PG8_SB(0, 1), cB + hstepB, voffB); PG8_STAGE(PG8_SA(0, 0), cA, voffA); PG8_STAGE(PG8_SA(0, 1), cA + hstepA, voffA);
        if (wr == 1) PG8_BAR;
        PG8_WAIT_V(2); PG8_BAR;
        PG8_STAGE(PG8_SB(1, 0), cB + kstep, voffB); PG8_STAGE(PG8_SA(1, 0), cA + kstep, voffA); PG8_STAGE(PG8_SB(1, 1), cB + hstepB + kstep, voffB);
        PG8_WAIT_V(6); PG8_BAR;
    } else {
        PG8_STAGE(PG8_SB(0, 0), cB, voffB); PG8_STAGE(PG8_SA(0, 0), cA, voffA); PG8_STAGE(PG8_SB(0, 1), cB + hstepB, voffB); PG8_STAGE(PG8_SA(0, 1), cA + hstepA, voffA);
        if (wr == 1) PG8_BAR;
        PG8_WAIT_V(4); PG8_BAR;
        PG8_STAGE(PG8_SB(1, 0), cB + kstep, voffB); PG8_STAGE(PG8_SA(1, 0), cA + kstep, voffA); PG8_STAGE(PG8_SB(1, 1), cB + hstepB + kstep, voffB);
        PG8_WAIT_V(6); PG8_BAR;
    }
    for (;;) {
        const bool has_next = S.next(ui + 1, nxt);
        const char* nA = has_next ? (const char*)g.A + S.a_off(nxt, tstepA) : cA; const char* nB = has_next ? (const char*)g.Bt + S.b_off(nxt, tstepB) : cB;
        for (int t = 0; t < nt; t += 2) {
            const bool last = (t == nt - 2);
            const char* a1 = cA + (size_t)(t + 1) * kstep;
            const char* a2 = last ? nA : cA + (size_t)(t + 2) * kstep; const char* b2 = last ? nB : cB + (size_t)(t + 2) * kstep;
            const char* a3 = a2 + kstep; const char* b3 = b2 + kstep;
            if (last && has_next) S.a_ready(nxt);
            if constexpr (Epi::PREFETCH) { if (last) E.prefetch(pre, cur, wr, wc, fr, fq); }
            if constexpr (SP2) {
            PG8_LDB(B0, 0, 0); PG8_LDB(B1, 0, 1); PG8_SCHED; PG8_LDA(At, 0, 0); PG8_STAGE(PG8_SA(1, 1), a1 + hstepA, voffA);
            PG8_WAIT_V(8); PG8_WAIT_L(0); PG8_BAR; PG8_MMA(0, 0, At, B0); PG8_MMA(0, 1, At, B1); PG8_BAR; PG8_SCHED;
            PG8_LDA(At, 0, 1); PG8_STAGE(PG8_SB(0, 0), b2, voffB); PG8_STAGE(PG8_SB(0, 1), b2 + hstepB, voffB); PG8_STAGE(PG8_SA(0, 0), a2, voffA);
            PG8_WAIT_V(8); PG8_WAIT_L(0); PG8_BAR; PG8_MMA(1, 0, At, B0); PG8_MMA(1, 1, At, B1); PG8_BAR; PG8_SCHED;
            PG8_LDB(B0, 1, 0); PG8_LDB(B1, 1, 1); PG8_SCHED; PG8_LDA(At, 1, 0); PG8_STAGE(PG8_SA(0, 1), a2 + hstepA, voffA);
            PG8_WAIT_V(8); PG8_WAIT_L(0); PG8_BAR; PG8_MMA(0, 0, At, B0); PG8_MMA(0, 1, At, B1); PG8_BAR; PG8_SCHED;
            PG8_LDA(At, 1, 1); PG8_STAGE(PG8_SB(1, 0), b3, voffB); PG8_STAGE(PG8_SB(1, 1), b3 + hstepB, voffB); PG8_STAGE(PG8_SA(1, 0), a3, voffA);
            PG8_WAIT_V(8); PG8_WAIT_L(0); PG8_BAR; PG8_MMA(1, 0, At, B0); PG8_MMA(1, 1, At, B1); PG8_BAR; PG8_SCHED;
            } else {
            PG8_LDB(B0, 0, 0); PG8_SCHED; PG8_LDA(At, 0, 0); PG8_STAGE(PG8_SA(1, 1), a1 + hstepA, voffA);
            PG8_WAIT_L(8); PG8_BAR; PG8_WAIT_L(0); PG8_MMA(0, 0, At, B0); PG8_BAR; PG8_SCHED;
            PG8_LDB(B1, 0, 1); PG8_STAGE(PG8_SB(0, 0), b2, voffB);
            PG8_BAR; PG8_WAIT_L(0); PG8_MMA(0, 1, At, B1); PG8_BAR;
            PG8_LDA(At, 0, 1); PG8_STAGE(PG8_SA(0, 0), a2, voffA);
            PG8_BAR; PG8_WAIT_L(0); PG8_MMA(1, 0, At, B0); PG8_BAR; PG8_SCHED;
            PG8_STAGE(PG8_SB(0, 1), b2 + hstepB, voffB);
            PG8_WAIT_V(6); PG8_BAR; PG8_MMA(1, 1, At, B1); PG8_BAR;
            PG8_LDB(B0, 1, 0); PG8_SCHED; PG8_LDA(At, 1, 0); PG8_STAGE(PG8_SA(0, 1), a2 + hstepA, voffA);
            PG8_WAIT_L(8); PG8_BAR; PG8_WAIT_L(0); PG8_MMA(0, 0, At, B0); PG8_BAR; PG8_SCHED;
            PG8_LDB(B1, 1, 1); PG8_STAGE(PG8_SB(1, 0), b3, voffB);
            PG8_BAR; PG8_WAIT_L(0); PG8_MMA(0, 1, At, B1); PG8_BAR;
            PG8_LDA(At, 1, 1); PG8_STAGE(PG8_SA(1, 0), a3, voffA);
            PG8_BAR; PG8_WAIT_L(0); PG8_MMA(1, 0, At, B0); PG8_BAR; PG8_SCHED;
            PG8_STAGE(PG8_SB(1, 1), b3 + hstepB, voffB);
            PG8_WAIT_V(6); PG8_BAR; PG8_MMA(1, 1, At, B1); PG8_BAR;
            }
        }
        if constexpr (ALIGN_EPI) { if (wr == 0) PG8_BAR; }
        if constexpr (!Epi::AFTER_DRAIN) { if constexpr (Epi::PREFETCH) E.with_pre(acc, pre, cur, wr, wc, fr, fq); else E(acc, cur, wr, wc, fr, fq); S.done(cur); }
        if (!has_next) break;
#pragma unroll
        for (int a = 0; a < 2; ++a)
#pragma unroll
            for (int b = 0; b < 2; ++b)
#pragma unroll
                for (int m = 0; m < 4; ++m)
#pragma unroll
                    for (int n = 0; n < 2; ++n) acc[a][b][m][n] = (f32x4){0.f, 0.f, 0.f, 0.f};
        cur = nxt; cA = nA; cB = nB; ++ui;
        if constexpr (ALIGN_EPI) { if (wr == 1) PG8_BAR; }
    }
    PG8_WAIT_V(0);
    if constexpr (!ALIGN_EPI) { if (wr == 0) PG8_BAR; }
    PG8_BAR;
    if constexpr (Epi::AFTER_DRAIN) { E.fused(acc, cur, wr, wc, fr, fq, lds, wid, lane); S.done(cur); }
#undef PG8_SA
#undef PG8_SB
#undef PG8_STAGE
#undef PG8_LDA
#undef PG8_LDB
#undef PG8_MMA
#undef PG8_WAIT_V
#undef PG8_WAIT_L
#undef PG8_BAR
#undef PG8_SCHED
}
}

constexpr int NWAVES = 8;
constexpr int T_ = 32768, D_ = 1024, SEQ_ = 8192, NB_ = 4, FF_ = 4096, ZC_ = 2560, QKC_ = 1536, INC_ = 3080;
constexpr float EPS_ = 1e-6f;
#ifndef MK_N_LAUNCHES
#define MK_N_LAUNCHES 1
#ifndef RUN_PHASES
#define RUN_PHASES 24
#ifndef REPMASK
#define REPMASK 0u
#endif
#define DBG_SRC WS_R1
#define DBG_F32 0
#define DBG_SAN 0
#endif
#endif
constexpr int NPH = 24;
constexpr int N_LAUNCHES = MK_N_LAUNCHES;

constexpr size_t MiB = 1u << 20;
constexpr size_t WS_CTL = 0, CTL_ZERO_BYTES = 1 * MiB;
constexpr size_t WS_WIN = 2 * MiB;
constexpr size_t WS_WOUT = 8 * MiB;
constexpr size_t WS_WQKV = 10 * MiB;
constexpr size_t WS_WSO = 13 * MiB;
constexpr size_t WS_WXQ = 15 * MiB;
constexpr size_t WS_BTALL = 19 * MiB;
constexpr size_t WS_AALL = 27 * MiB;
constexpr size_t WS_WXO = 35 * MiB;
constexpr size_t WS_WFF1 = 39 * MiB;
constexpr size_t WS_WFF2 = 55 * MiB;
constexpr size_t WS_RGW = 71 * MiB;
constexpr size_t WS_KV = 72 * MiB;
constexpr size_t WS_ROPE = 80 * MiB;
constexpr size_t WS_GIF = 88 * MiB;
constexpr size_t WS_NU = 89 * MiB;
constexpr size_t WS_NPREV = 90 * MiB;
constexpr size_t WS_ACH = 91 * MiB;
constexpr size_t WS_HCH = 92 * MiB;
constexpr size_t WS_HIN = 93 * MiB;
constexpr size_t WS_SCAL = 94 * MiB;
constexpr size_t WS_RS = 95 * MiB;
constexpr size_t WS_R1 = 96 * MiB;
constexpr size_t WS_R2 = 160 * MiB;
constexpr size_t WS_R3 = 352 * MiB;
constexpr size_t WS_R4 = 416 * MiB;
constexpr size_t WS_MB = 480 * MiB;
constexpr size_t WS_VWB = 496 * MiB;
constexpr size_t WS_END = 512 * MiB;
constexpr int CW_TMO = 0, CW_CODE = 1, CW_BAR = 4096, CW_GRP = 32768;

constexpr int RING_OFF = 0, RING_BYTES = 131072;
constexpr int LDSCTL_OFF = 143360, MISC_OFF = LDSCTL_OFF + 320;
constexpr int LDS_BYTES = 147456;

#define GAS __attribute__((address_space(1)))
#define LAS __attribute__((address_space(3)))
typedef unsigned short bf16;
typedef unsigned v4u __attribute__((ext_vector_type(4)));
typedef unsigned v2u __attribute__((ext_vector_type(2)));
typedef float f32x4 __attribute__((ext_vector_type(4)));
typedef float f32x16 __attribute__((ext_vector_type(16)));
typedef short bf16x8 __attribute__((ext_vector_type(8)));
typedef short s16x4 __attribute__((ext_vector_type(4)));
typedef GAS unsigned gu32;
#define RLX_AGENT __ATOMIC_RELAXED, __HIP_MEMORY_SCOPE_AGENT
#define LDS_WAIT() asm volatile("s_waitcnt lgkmcnt(0)" ::: "memory")
#define VM_WAIT() asm volatile("s_waitcnt vmcnt(0)" ::: "memory")
#define MFMA32(a, b, c) __builtin_amdgcn_mfma_f32_32x32x16_bf16((a), (b), (c), 0, 0, 0)
typedef float f32x2_t __attribute__((ext_vector_type(2))); typedef __bf16 bf16x2_t __attribute__((ext_vector_type(2)));
__device__ __forceinline__ unsigned pk2(float lo, float hi) { const f32x2_t v = {lo, hi}; const bf16x2_t b = __builtin_convertvector(v, bf16x2_t); return __builtin_bit_cast(unsigned, b); }
__device__ __forceinline__ float bflo(unsigned w) { return __uint_as_float(w << 16); }
__device__ __forceinline__ float bfhi(unsigned w) { return __uint_as_float(w & 0xffff0000u); }
__device__ __forceinline__ float bfs(short s) { return __uint_as_float(((unsigned)(unsigned short)s) << 16); }
__device__ __forceinline__ float fsigmoid(float x) { return __builtin_amdgcn_rcpf(1.0f + __expf(-x)); }
__device__ __forceinline__ float logsig(float x) { return fminf(x, 0.f) - log1pf(__expf(-fabsf(x))); }
__device__ __forceinline__ float wave_sum(float v) {
#pragma unroll
    for (int o = 1; o < 64; o <<= 1) v += __shfl_xor(v, o);
    return v;
}
__device__ __forceinline__ float wave_max(float v) {
#pragma unroll
    for (int o = 1; o < 64; o <<= 1) v = fmaxf(v, __shfl_xor(v, o));
    return v;
}
__device__ __forceinline__ float wave_scan_add(float v, int lane) {
#pragma unroll
    for (int o = 1; o < 64; o <<= 1) { const float t = __shfl_up(v, o); if (lane >= o) v += t; }
    return v;
}
__device__ __forceinline__ float wave_scan_max(float v, int lane) {
#pragma unroll
    for (int o = 1; o < 64; o <<= 1) { const float t = __shfl_up(v, o); if (lane >= o) v = fmaxf(v, t); }
    return v;
}
__device__ __forceinline__ bf16x8 ldg8(const bf16* p) { return *(const bf16x8*)p; }
__device__ __forceinline__ bf16x8 ld_perm8(const bf16* p) { const s16x4 a = *(const s16x4*)p, b = *(const s16x4*)(p + 8); return (bf16x8){a[0], a[1], a[2], a[3], b[0], b[1], b[2], b[3]}; }
__device__ __forceinline__ bf16x8 pack8(float a0, float a1, float a2, float a3, float a4, float a5, float a6, float a7) {
    v4u w; w.x = pk2(a0, a1); w.y = pk2(a2, a3); w.z = pk2(a4, a5); w.w = pk2(a6, a7); return __builtin_bit_cast(bf16x8, w); }

struct Args { const void* in[28]; float* out; unsigned char* ws; int ph_lo, ph_hi; };
#define XB_TMO      128
#define XB_XCNT(j)  (256  + 64 * (j))
#define XB_XSUB(j)  (1280 + 64 * (j))
#define XB_XGEN(j)  (2304 + 64 * (j))
#define XB_TOP      3328
#define XB_TOPGEN   3392
#define XCD_BAR_WORDS 3456
#define XB_SPIN_CAP (1u << 18)

__device__ __forceinline__ unsigned xb_ld(unsigned* p)              { return __hip_atomic_load(p, __ATOMIC_RELAXED, __HIP_MEMORY_SCOPE_AGENT); }
__device__ __forceinline__ unsigned xb_add(unsigned* p, unsigned v) { return __hip_atomic_fetch_add(p, v, __ATOMIC_RELAXED, __HIP_MEMORY_SCOPE_AGENT); }
__device__ __forceinline__ unsigned xb_xcc_id() { return (unsigned)__builtin_amdgcn_s_getreg((3 << 11) | 20) & 0xFu; }
#define XB_SPIN(cond, bar) do { unsigned _sp = 0; while (cond) { __builtin_amdgcn_s_sleep(1); \
    if ((++_sp & 255u) == 0u) { if (xb_ld(&(bar)[XB_TMO])) break; if (_sp > XB_SPIN_CAP) { atomicAdd(&(bar)[XB_TMO], 1u); break; } } } } while (0)

struct XcdBarrier {
    unsigned* bar; unsigned x;
    volatile LAS unsigned* st;
};

__device__ __forceinline__ XcdBarrier xcd_barrier_post(unsigned* bar, volatile LAS unsigned* st) {
    XcdBarrier b; b.bar = bar; b.x = xb_xcc_id(); b.st = st;
    if (threadIdx.x == 0) (void)xb_add(&bar[XB_XCNT(b.x)], 1u);
    return b;
}
__device__ __forceinline__ void xcd_barrier_complete(unsigned* bar, unsigned x, unsigned& nloc, unsigned& nx) {
    const unsigned G = gridDim.x * gridDim.y * gridDim.z;
    unsigned sum, cnt, mine, sp = 0u;
    for (;;) {
        sum = 0u; cnt = 0u; mine = 0u;
#pragma unroll
        for (unsigned j = 0; j < 16; ++j) { const unsigned c = xb_ld(&bar[XB_XCNT(j)]); sum += c; cnt += (c > 0u) ? 1u : 0u; mine = (j == x) ? c : mine; }
        if (sum == G) break;
        __builtin_amdgcn_s_sleep(1);
        if ((++sp & 255u) == 0u) { if (xb_ld(&bar[XB_TMO])) break; if (sp > XB_SPIN_CAP) { atomicAdd(&bar[XB_TMO], 1u); break; } }
    }
    nloc = mine > 0u ? mine : 1u; nx = cnt > 0u ? cnt : 1u;
}

__device__ __forceinline__ void xcd_barrier(const XcdBarrier& b) {
    asm volatile("s_waitcnt vmcnt(0)" ::: "memory");
    __syncthreads();
    if (threadIdx.x == 0) {
        unsigned* bar = b.bar;
        __builtin_amdgcn_s_waitcnt(0);
        unsigned nloc = b.st[0], nx = b.st[1];
        if (nloc == 0u) { xcd_barrier_complete(bar, b.x, nloc, nx); b.st[0] = nloc; b.st[1] = nx; }
        const unsigned old = xb_add(&bar[XB_XSUB(b.x)], 1u);
        const unsigned gen = old / nloc;
        if (old + 1u == (gen + 1u) * nloc) {
            __builtin_amdgcn_fence(__ATOMIC_RELEASE, "agent");
            asm volatile("s_waitcnt vmcnt(0)" ::: "memory");
            const unsigned og = xb_add(&bar[XB_TOP], 1u);
            const unsigned tg = og / nx;
            if (og + 1u == (tg + 1u) * nx) xb_add(&bar[XB_TOPGEN], 1u);
            else XB_SPIN(xb_ld(&bar[XB_TOPGEN]) == tg, bar);
            __builtin_amdgcn_fence(__ATOMIC_ACQUIRE, "agent");
            xb_add(&bar[XB_XGEN(b.x)], 1u);
            asm volatile("s_waitcnt vmcnt(0)" ::: "memory");
        } else {
            XB_SPIN(xb_ld(&bar[XB_XGEN(b.x)]) == gen, bar);
            __builtin_amdgcn_fence(__ATOMIC_ACQUIRE, "agent");
            asm volatile("s_waitcnt vmcnt(0)" ::: "memory");
        }
    }
    __syncthreads();
}

struct Frame { LAS unsigned char* lds; int tid, lane, wave, G; int grp, mem; };

__device__ __forceinline__ int srccol(int kind, int n) {
    if (kind == 1) return n < 512 ? 1024 + n : (n < 1024 ? n : (n < 1536 ? n - 1024 : (n < 2048 ? n : n + 8)));
    if (kind == 2) { if (n >= 1280) return n; const int hd = n >> 6, p = n & 63; return hd * 64 + (p >> 1) + 32 * (p & 1); }
    return n;
}
__device__ __forceinline__ void p0_transpose_item(const float* W, int K, int N, int ndst, int col_off, int kind, bf16* WT, LAS float* scr, int item, int lane, const float* gk = nullptr) {
    const int nblk = ndst / 32, kb = item / nblk, nb = item % nblk, k0 = 64 * kb, n0 = 32 * nb;
    const int n = n0 + (lane & 31); const int sc = srccol(kind, n) + col_off;
    const float scale = (kind == 1 && n >= 512 && n < 1024) ? 0.08838834764831845f : 1.0f;
    float wv[32];
#pragma unroll
    for (int i = 0; i < 32; ++i) wv[i] = W[(size_t)(k0 + 2 * i + (lane >> 5)) * N + sc];
#pragma unroll
    for (int i = 0; i < 32; ++i) { const int kk = 2 * i + (lane >> 5); scr[kk * 33 + (lane & 31)] = wv[i] * (gk ? scale * gk[k0 + kk] : scale); }
    LDS_WAIT(); asm volatile("" ::: "memory");
    const int c = lane & 7;
#pragma unroll
    for (int j = 0; j < 4; ++j) { const int nn = (lane >> 3) + 8 * j; const LAS float* s = scr + (8 * c) * 33 + nn;
        v4u o; o.x = pk2(s[0 * 33], s[1 * 33]); o.y = pk2(s[2 * 33], s[3 * 33]); o.z = pk2(s[4 * 33], s[5 * 33]); o.w = pk2(s[6 * 33], s[7 * 33]);
        *(v4u*)(WT + (size_t)(n0 + nn) * K + k0 + 8 * c) = o; }
    LDS_WAIT(); asm volatile("" ::: "memory");
}
__device__ __forceinline__ void rms_row_to_bf16(const float* xrow, const float* g, bf16* o1, bf16* o2, int lane) {
    const f32x4* xr = (const f32x4*)xrow + lane; const f32x4* gr = (const f32x4*)g + lane;
    f32x4 v[4]; float s = 0.f;
#pragma unroll
    for (int j = 0; j < 4; ++j) { v[j] = xr[64 * j]; s += (v[j].x * v[j].x + v[j].y * v[j].y) + (v[j].z * v[j].z + v[j].w * v[j].w); }
    const float r = rsqrtf(wave_sum(s) * (1.f / 1024.f) + EPS_);
#pragma unroll
    for (int j = 0; j < 4; ++j) { const f32x4 gg = gr[64 * j]; v2u w; w.x = pk2(v[j].x * r * gg.x, v[j].y * r * gg.y); w.y = pk2(v[j].z * r * gg.z, v[j].w * r * gg.w);
        *((v2u*)o1 + lane + 64 * j) = w; *((v2u*)o2 + lane + 64 * j) = w; }
}

__device__ __forceinline__ void p0_prologue(const Frame& F, const Args& a) {
    unsigned char* ws = a.ws;
    LAS float* scr = (LAS float*)(F.lds + RING_OFF + F.wave * 16384);
    const int gw = blockIdx.x * NWAVES + F.wave, NGW = F.G * NWAVES;
    constexpr int I_SQ = 16 * 32, I_IN = 16 * 96, I_QKV = 16 * 48, I_FF1 = 16 * 128, I_FF2 = 64 * 32;
    constexpr int NITEMS = I_IN + I_SQ + I_QKV + I_SQ + 4 * I_SQ + 2 * I_SQ + 2 * I_FF1 + 2 * I_FF2;
    const float* w_in = (const float*)a.in[3]; const float* w_out = (const float*)a.in[12]; const float* w_qkv = (const float*)a.in[13]; const float* w_so = (const float*)a.in[15];
    const float* w_xq = (const float*)a.in[21]; const float* w_xkv = (const float*)a.in[22]; const float* w_xo = (const float*)a.in[23]; const float* w_ff1 = (const float*)a.in[26]; const float* w_ff2 = (const float*)a.in[27];
    for (int it = gw; it < NITEMS; it += NGW) {
        int r = it;
        if (r < I_IN) { p0_transpose_item(w_in, 1024, INC_, 3072, 0, 1, (bf16*)(ws + WS_WIN), scr, r, F.lane, (const float*)a.in[16]); continue; } r -= I_IN;
        if (r < I_SQ) { p0_transpose_item(w_out, 1024, 1024, 1024, 0, 0, (bf16*)(ws + WS_WOUT), scr, r, F.lane); continue; } r -= I_SQ;
        if (r < I_QKV) { p0_transpose_item(w_qkv, 1024, 1536, 1536, 0, 2, (bf16*)(ws + WS_WQKV), scr, r, F.lane, (const float*)a.in[16] + 1024); continue; } r -= I_QKV;
        if (r < I_SQ) { p0_transpose_item(w_so, 1024, 1024, 1024, 0, 0, (bf16*)(ws + WS_WSO), scr, r, F.lane); continue; } r -= I_SQ;
        if (r < 4 * I_SQ) { const int l = r / (2 * I_SQ); p0_transpose_item(w_xkv + (size_t)l * 2097152, 1024, 2048, 2048, 0, 0, (bf16*)(ws + WS_BTALL) + (size_t)l * 2097152, scr, r % (2 * I_SQ), F.lane); continue; } r -= 4 * I_SQ;
        if (r < 2 * I_SQ) { const int l = r / I_SQ; p0_transpose_item(w_xo + (size_t)l * 1048576, 1024, 1024, 1024, 0, 0, (bf16*)(ws + WS_WXO) + (size_t)l * 1048576, scr, r % I_SQ, F.lane); continue; } r -= 2 * I_SQ;
        if (r < 2 * I_FF1) { const int l = r / I_FF1; p0_transpose_item(w_ff1 + (size_t)l * 4194304, 1024, 4096, 4096, 0, 0, (bf16*)(ws + WS_WFF1) + (size_t)l * 4194304, scr, r % I_FF1, F.lane, (const float*)a.in[24] + l * 1024); continue; } r -= 2 * I_FF1;
        { const int l = r / I_FF2; p0_transpose_item(w_ff2 + (size_t)l * 4194304, 4096, 1024, 1024, 0, 0, (bf16*)(ws + WS_WFF2) + (size_t)l * 4194304, scr, r % I_FF2, F.lane); }
    }
    const int gt = blockIdx.x * (NWAVES * 64) + F.tid, NGT = F.G * NWAVES * 64;
    { const float* wa = (const float*)a.in[7]; const float* wx = (const float*)a.in[9]; bf16* o = (bf16*)(ws + WS_RGW);
      for (int i = gt; i < 2 * 65536; i += NGT) { const int which = i >> 16, e = i & 65535, n = e >> 14, d = (e >> 7) & 127, c = e & 127;
          const float v = (which ? wx : wa)[n * 16384 + c * 128 + d]; o[i] = (bf16)(pk2(v, 0.f) & 0xffffu); } }
    { const float* gx = (const float*)a.in[18]; bf16* o = (bf16*)(ws + WS_WXQ);
      for (int i0 = gt; i0 < 2 * 1048576 / 2; i0 += 8 * NGT) { float2 v[8]; float g[8];
#pragma unroll
          for (int u = 0; u < 8; ++u) { const int i = i0 + u * NGT; if (i < 1048576) { v[u] = ((const float2*)w_xq)[i]; g[u] = gx[(i >> 19) * 1024 + ((i >> 9) & 1023)]; } }
#pragma unroll
          for (int u = 0; u < 8; ++u) { const int i = i0 + u * NGT; if (i < 1048576) ((unsigned*)o)[i] = pk2(v[u].x * g[u], v[u].y * g[u]); } } }
    { const float* lam = (const float*)a.in[11]; float* sp = (float*)(ws + WS_SCAL) + 3 * 2048;
      for (int i = gt; i < 512; i += NGT) { const float x = -lam[i]; sp[i] = 8.0f * (fmaxf(x, 0.f) + log1pf(__expf(-fabsf(x)))); } }
    { const int* pos = (const int*)a.in[2]; float* cs = (float*)(ws + WS_ROPE);
      const float inv = (float)exp2(-(double)(gt & 31) * (13.287712379549449 / 32.0));
      for (int i0 = gt; i0 < T_ * 32; i0 += 8 * NGT) { int pv[8];
#pragma unroll
          for (int u = 0; u < 8; ++u) { const int i = i0 + u * NGT; pv[u] = (i < T_ * 32) ? pos[i >> 5] : 0; }
#pragma unroll
          for (int u = 0; u < 8; ++u) { const int i = i0 + u * NGT; if (i < T_ * 32) {
              const float ang = (float)pv[u] * inv;
              const double rev = (double)ang * 0.15915494309189535; const float fr = (float)(rev - floor(rev));
              *(float2*)(cs + 2 * i) = make_float2(__builtin_amdgcn_cosf(fr), __builtin_amdgcn_sinf(fr)); } } } }
    { const float* mem = (const float*)a.in[1]; const float* gm = (const float*)a.in[20];
      for (int m = gw; m < 2048; m += NGW) { const int l = m >> 10, row = m & 1023;
          bf16* mo = (bf16*)(ws + WS_AALL) + (size_t)l * 1048576 + (size_t)row * 1024; rms_row_to_bf16(mem + (size_t)row * 1024, gm + l * 1024, mo, mo, F.lane); } }
}

template <int MODE, bool HF32, bool GROUPED = false> __device__ __forceinline__ void norm_phase(const Frame& F, const bf16* y, const float* gpost, const void* hin, bf16* Hout, float* RSout, float* outf, const float* gpre,
                                                                           int wg0, const float* w_in, const float* b_if, float* gif, int ldy = 1024) {
    const int lane = F.lane; const int nwg = F.G - wg0; if ((int)blockIdx.x < wg0) return;
    const int gw = ((int)blockIdx.x - wg0) * NWAVES + F.wave, NGW = nwg * NWAVES;
    LAS float* wif = (LAS float*)(F.lds + RING_OFF);
    if (MODE == 0) { for (int i = F.tid; i < 8192; i += NWAVES * 64) { const int k = i >> 3, c = i & 7; wif[c * 1024 + k] = w_in[(size_t)k * INC_ + 2048 + c]; } __syncthreads(); }
    float g[16];
#pragma unroll
    for (int hf = 0; hf < 2; ++hf)
#pragma unroll
        for (int e = 0; e < 8; ++e) g[8 * hf + e] = (MODE == 0) ? gpre[512 * hf + 8 * lane + e] : gpost[512 * hf + 8 * lane + e];
    const __amdgpu_buffer_rsrc_t hrs_ = __builtin_amdgcn_make_buffer_rsrc((void*)Hout, 0, 0x7fffffff, 0x00020000), rrs_ = __builtin_amdgcn_make_buffer_rsrc((void*)RSout, 0, 0x7fffffff, 0x00020000);
    const int r_begin = GROUPED ? 512 * F.grp + 128 * F.mem + F.wave : gw, r_end = GROUPED ? 512 * F.grp + 128 * F.mem + 128 : T_, r_step = GROUPED ? 16 : 2 * NGW, r_second = GROUPED ? 8 : NGW;
    const int rot = GROUPED ? ((4 * F.grp + F.mem) * 5) & 7 : 0;
    f32x4 nx[2][4];
    if (MODE == 0) {
#pragma unroll
        for (int rr = 0; rr < 2; ++rr) { const int row = r_begin + rr * r_second;
#pragma unroll
            for (int q = 0; q < 4; ++q) nx[rr][q] = (row < T_) ? *((const f32x4*)((const float*)hin + (size_t)row * 1024 + 512 * (q >> 1) + 8 * lane) + (q & 1)) : (f32x4){0.f, 0.f, 0.f, 0.f}; } }
    for (int rowi = r_begin; rowi < r_end; rowi += r_step) {
        const int row0 = GROUPED ? r_begin + 16 * ((((rowi - r_begin) >> 4) + rot) & 7) : rowi;
        float hv[2][16], yv[2][16];
        if (MODE == 0) {
#pragma unroll
            for (int rr = 0; rr < 2; ++rr)
#pragma unroll
                for (int q = 0; q < 4; ++q) { hv[rr][4 * q] = nx[rr][q][0]; hv[rr][4 * q + 1] = nx[rr][q][1]; hv[rr][4 * q + 2] = nx[rr][q][2]; hv[rr][4 * q + 3] = nx[rr][q][3]; }
#pragma unroll
            for (int rr = 0; rr < 2; ++rr) { const int row = rowi + r_step + rr * r_second;
#pragma unroll
                for (int q = 0; q < 4; ++q) nx[rr][q] = (row < T_) ? *((const f32x4*)((const float*)hin + (size_t)row * 1024 + 512 * (q >> 1) + 8 * lane) + (q & 1)) : (f32x4){0.f, 0.f, 0.f, 0.f}; }
        }
#pragma unroll
        for (int rr = 0; rr < 2; ++rr) { const int row = row0 + rr * r_second; if (MODE != 0 && row < T_) {
#pragma unroll
            for (int hf = 0; hf < 2; ++hf) {
                if (MODE == 0 || HF32) { const f32x4* hp = (const f32x4*)((const float*)hin + (size_t)row * 1024 + 512 * hf + 8 * lane); const f32x4 a = hp[0], b = hp[1];
                    hv[rr][8 * hf + 0] = a[0]; hv[rr][8 * hf + 1] = a[1]; hv[rr][8 * hf + 2] = a[2]; hv[rr][8 * hf + 3] = a[3]; hv[rr][8 * hf + 4] = b[0]; hv[rr][8 * hf + 5] = b[1]; hv[rr][8 * hf + 6] = b[2]; hv[rr][8 * hf + 7] = b[3]; }
                else { const v4u hw = *(const v4u*)((const bf16*)hin + (size_t)row * 1024 + 512 * hf + 8 * lane);
                    hv[rr][8 * hf + 0] = bflo(hw.x); hv[rr][8 * hf + 1] = bfhi(hw.x); hv[rr][8 * hf + 2] = bflo(hw.y); hv[rr][8 * hf + 3] = bfhi(hw.y); hv[rr][8 * hf + 4] = bflo(hw.z); hv[rr][8 * hf + 5] = bfhi(hw.z); hv[rr][8 * hf + 6] = bflo(hw.w); hv[rr][8 * hf + 7] = bfhi(hw.w); }
                if (MODE != 0) { const v4u yw = *(const v4u*)(y + (size_t)row * ldy + 512 * hf + 8 * lane);
                    yv[rr][8 * hf + 0] = bflo(yw.x); yv[rr][8 * hf + 1] = bfhi(yw.x); yv[rr][8 * hf + 2] = bflo(yw.y); yv[rr][8 * hf + 3] = bfhi(yw.y); yv[rr][8 * hf + 4] = bflo(yw.z); yv[rr][8 * hf + 5] = bfhi(yw.z); yv[rr][8 * hf + 6] = bflo(yw.w); yv[rr][8 * hf + 7] = bfhi(yw.w); }
            } } }
#pragma unroll
        for (int rr = 0; rr < 2; ++rr) { const int row = row0 + rr * r_second; if (row < T_) {
            if (MODE != 0) {
                float s = 0.f;
#pragma unroll
                for (int e = 0; e < 16; ++e) s += yv[rr][e] * yv[rr][e];
                const float r = rsqrtf(wave_sum(s) * (1.f / 1024.f) + EPS_);
#pragma unroll
                for (int e = 0; e < 16; ++e) hv[rr][e] += yv[rr][e] * r * g[e];
            }
            if (MODE == 2) {
#pragma unroll
                for (int hf = 0; hf < 2; ++hf) { f32x4* op = (f32x4*)(outf + (size_t)row * 1024 + 512 * hf + 8 * lane);
                    op[0] = (f32x4){hv[rr][8 * hf], hv[rr][8 * hf + 1], hv[rr][8 * hf + 2], hv[rr][8 * hf + 3]}; op[1] = (f32x4){hv[rr][8 * hf + 4], hv[rr][8 * hf + 5], hv[rr][8 * hf + 6], hv[rr][8 * hf + 7]}; }
            } else {
                float s = 0.f;
#pragma unroll
                for (int e = 0; e < 16; ++e) s += hv[rr][e] * hv[rr][e];
                const float r = rsqrtf(wave_sum(s) * (1.f / 1024.f) + EPS_);
#pragma unroll
                for (int hf = 0; hf < 2; ++hf) { v4u w; w.x = pk2(hv[rr][8 * hf], hv[rr][8 * hf + 1]); w.y = pk2(hv[rr][8 * hf + 2], hv[rr][8 * hf + 3]); w.z = pk2(hv[rr][8 * hf + 4], hv[rr][8 * hf + 5]); w.w = pk2(hv[rr][8 * hf + 6], hv[rr][8 * hf + 7]);
                    if (GROUPED) __builtin_amdgcn_raw_buffer_store_b128(w, hrs_, (int)(((size_t)row * 1024 + 512 * hf + 8 * lane) * 2), 0, 16); else *(v4u*)(Hout + (size_t)row * 1024 + 512 * hf + 8 * lane) = w; }
                if (lane == 0) { if (GROUPED) __builtin_amdgcn_raw_buffer_store_b32(__float_as_uint(r), rrs_, row * 4, 0, 16); else RSout[row] = r; }
                if (MODE == 0) {
                    float g8[8];
#pragma unroll
                    for (int c = 0; c < 8; ++c) { float acc = 0.f;
#pragma unroll
                        for (int hf = 0; hf < 2; ++hf) { const f32x4 w0 = *(const LAS f32x4*)(wif + c * 1024 + 512 * hf + 8 * lane), w1 = *(const LAS f32x4*)(wif + c * 1024 + 512 * hf + 8 * lane + 4);
                            acc += hv[rr][8 * hf] * g[8 * hf] * w0[0] + hv[rr][8 * hf + 1] * g[8 * hf + 1] * w0[1] + hv[rr][8 * hf + 2] * g[8 * hf + 2] * w0[2] + hv[rr][8 * hf + 3] * g[8 * hf + 3] * w0[3]
                                 + hv[rr][8 * hf + 4] * g[8 * hf + 4] * w1[0] + hv[rr][8 * hf + 5] * g[8 * hf + 5] * w1[1] + hv[rr][8 * hf + 6] * g[8 * hf + 6] * w1[2] + hv[rr][8 * hf + 7] * g[8 * hf + 7] * w1[3]; }
                        g8[c] = wave_sum(acc) * r; }
                    float mine = 0.f;
#pragma unroll
                    for (int c = 0; c < 8; ++c) mine = (lane == c) ? g8[c] : mine;
                    if (lane < 8) gif[(size_t)row * 8 + lane] = mine + b_if[lane];
                }
            }
        } }
    }
}

__device__ __forceinline__ void mlstm_A(const Frame& F, const bf16* Z, const bf16* ZT, const float* GIF, bf16* UT, float* NU, float* MLOC, float* BLAST) {
    const int lane = F.lane, w = F.wave, c = lane & 31, hl = lane >> 5;
    LAS float* wsc = (LAS float*)(F.lds + RING_OFF + w * 17920);
    LAS unsigned char* tb_ = F.lds + RING_OFF + w * 17920 + 1024;
    for (int unit = blockIdx.x * NWAVES + w; unit < 2048; unit += F.G * NWAVES) {
        const int bh = unit >> 7, j = unit & 127, b = bh >> 2, h = bh & 3; const size_t t0 = (size_t)b * SEQ_ + 64 * j;
        const float fg = GIF[(t0 + lane) * 8 + 4 + h], ig = GIF[(t0 + lane) * 8 + h];
        bf16x8 va[4][4];
        {
            const char* vtb = (const char*)(ZT + (size_t)(h * 128) * T_ + t0); unsigned vlo = (unsigned)(lane >> 3) * (unsigned)(T_ * 2) + (unsigned)(lane & 7) * 16u; asm volatile("" : "+v"(vlo));
#pragma unroll
            for (int half = 0; half < 2; ++half) { v4u t_[8];
#pragma unroll
                for (int i = 0; i < 8; ++i) t_[i] = *(const v4u*)(vtb + (vlo + (unsigned)(64 * half + 8 * i) * (unsigned)(T_ * 2)));
#pragma unroll
                for (int i = 0; i < 8; ++i) *(LAS v4u*)(tb_ + (8 * i + (lane >> 3)) * 144 + (lane & 7) * 16) = t_[i];
                LDS_WAIT();
#pragma unroll
                for (int dvl = 0; dvl < 2; ++dvl)
#pragma unroll
                    for (int kq = 0; kq < 4; ++kq) { const LAS unsigned char* vp = tb_ + (32 * dvl + c) * 144 + (16 * kq + 4 * hl) * 2;
                        const s16x4 a_ = *(const LAS s16x4*)vp, b_ = *(const LAS s16x4*)(vp + 16); va[2 * half + dvl][kq] = (bf16x8){a_[0], a_[1], a_[2], a_[3], b_[0], b_[1], b_[2], b_[3]}; }
                LDS_WAIT(); }
        }
        const float bcum = wave_scan_add(logsig(fg), lane);
        const float blast = __shfl(bcum, 63);
        const float g = blast - bcum + ig;
        const float mloc = wave_max(g);
        wsc[lane] = __expf(g - mloc);
        LDS_WAIT();
        f32x4 wq[4][2];
#pragma unroll
        for (int kq = 0; kq < 4; ++kq) { wq[kq][0] = *(const LAS f32x4*)(wsc + 16 * kq + 4 * hl); wq[kq][1] = *(const LAS f32x4*)(wsc + 16 * kq + 8 + 4 * hl); }
#pragma unroll
        for (int dvb = 0; dvb < 4; ++dvb)
#pragma unroll
            for (int kq = 0; kq < 4; ++kq) { const bf16x8 v = va[dvb][kq];
                va[dvb][kq] = pack8(bfs(v[0]) * wq[kq][0][0], bfs(v[1]) * wq[kq][0][1], bfs(v[2]) * wq[kq][0][2], bfs(v[3]) * wq[kq][0][3], bfs(v[4]) * wq[kq][1][0], bfs(v[5]) * wq[kq][1][1], bfs(v[6]) * wq[kq][1][2], bfs(v[7]) * wq[kq][1][3]); }
        const char* zkb = (const char*)(Z + t0 * ZC_ + h * 128);
        char* utb = (char*)(UT + (size_t)unit * 16384);
        unsigned klo = (unsigned)(lane >> 2) * (ZC_ * 2) + (unsigned)(lane & 3) * 16u; asm volatile("" : "+v"(klo));
        v4u kn[4];
#pragma unroll
        for (int i = 0; i < 4; ++i) kn[i] = *(const v4u*)(zkb + (klo + (unsigned)(16 * i) * (ZC_ * 2)));
#pragma unroll 1
        for (int dkb = 0; dkb < 4; ++dkb) {
#pragma unroll
            for (int i = 0; i < 4; ++i) *(LAS v4u*)(tb_ + ((lane >> 2) + 16 * i) * 64 + (lane & 3) * 16) = kn[i];
            { unsigned lo2 = klo + 64u * (unsigned)((dkb + 1) & 3); asm volatile("" : "+v"(lo2));
#pragma unroll
              for (int i = 0; i < 4; ++i) kn[i] = *(const v4u*)(zkb + (lo2 + (unsigned)(16 * i) * (ZC_ * 2))); }
            LDS_WAIT();
            unsigned xr[2][16];
#pragma unroll
            for (int sb = 0; sb < 2; ++sb)
#pragma unroll
                for (int r = 0; r < 16; ++r) xr[sb][r] = *(const LAS bf16*)(tb_ + (32 * sb + (r & 3) + 8 * (r >> 2) + 4 * hl) * 64 + 2 * c);
            float sn = 0.f; bf16x8 kb[4];
#pragma unroll
            for (int sb = 0; sb < 2; ++sb)
#pragma unroll
                for (int sp = 0; sp < 2; ++sp) { const int kq = 2 * sb + sp; v4u pw;
                    pw.x = xr[sb][8 * sp + 0] | (xr[sb][8 * sp + 1] << 16); pw.y = xr[sb][8 * sp + 2] | (xr[sb][8 * sp + 3] << 16); pw.z = xr[sb][8 * sp + 4] | (xr[sb][8 * sp + 5] << 16); pw.w = xr[sb][8 * sp + 6] | (xr[sb][8 * sp + 7] << 16);
                    kb[kq] = __builtin_bit_cast(bf16x8, pw);
#pragma unroll
                    for (int e = 0; e < 4; ++e) sn += __uint_as_float(xr[sb][8 * sp + e] << 16) * wq[kq][0][e] + __uint_as_float(xr[sb][8 * sp + 4 + e] << 16) * wq[kq][1][e]; }
            sn += __shfl_xor(sn, 32);
            if (hl == 0) NU[(size_t)unit * 128 + 32 * dkb + c] = sn;
            f32x16 acc[4] = {{}, {}, {}, {}};
#pragma unroll
            for (int kq = 0; kq < 4; ++kq)
#pragma unroll
                for (int dvb = 0; dvb < 4; ++dvb) acc[dvb] = MFMA32(kb[kq], va[dvb][kq], acc[dvb]);
#pragma unroll
            for (int dvb = 0; dvb < 4; ++dvb)
#pragma unroll
                for (int g4 = 0; g4 < 4; ++g4) { v2u pw; pw.x = pk2(acc[dvb][4 * g4], acc[dvb][4 * g4 + 1]); pw.y = pk2(acc[dvb][4 * g4 + 2], acc[dvb][4 * g4 + 3]);
                    *(LAS v2u*)(tb_ + 4096 + (32 * dvb + c) * 80 + (8 * g4 + 4 * hl) * 2) = pw; }
            LDS_WAIT();
            { unsigned so = (unsigned)(lane >> 2) * 256u + (unsigned)(lane & 3) * 16u + 64u * (unsigned)dkb; asm volatile("" : "+v"(so));
#pragma unroll
              for (int i = 0; i < 8; ++i) { const v4u v = *(const LAS v4u*)(tb_ + 4096 + ((lane >> 2) + 16 * i) * 80 + (lane & 3) * 16); *(v4u*)(utb + (so + (unsigned)(16 * i) * 256u)) = v; } }
            LDS_WAIT();
        }
        if (lane == 0) { MLOC[unit] = mloc; BLAST[unit] = blast; }
        LDS_WAIT();
    }
}
__device__ __forceinline__ void mlstm_B(const Frame& F, const bf16* UT, const float* NU, const float* MLOC, const float* BLAST, bf16* CT, float* NPREV, float* MPREV) {
    const unsigned* U32 = (const unsigned*)UT; unsigned* C32 = (unsigned*)CT;
    constexpr int NB = 32;
    for (int g = blockIdx.x * (NWAVES * 64) + F.tid; g < 16 * 8192; g += F.G * NWAVES * 64) {
        const int bh = __builtin_amdgcn_readfirstlane(g >> 13), e2 = g & 8191;
        float m = 0.f, c0 = 0.f, c1 = 0.f, n0 = 0.f, n1 = 0.f;
        unsigned un[NB];
        int mlvn = __float_as_int(MLOC[bh * 128 + (F.lane & (NB - 1))]), blvn = __float_as_int(BLAST[bh * 128 + (F.lane & (NB - 1))]);
#pragma unroll
        for (int jj = 0; jj < NB; ++jj) un[jj] = __builtin_nontemporal_load(U32 + (size_t)(bh * 128 + jj) * 8192 + e2);
#pragma unroll 1
        for (int j0 = 0; j0 < 128; j0 += NB) {
            unsigned u[NB];
#pragma unroll
            for (int jj = 0; jj < NB; ++jj) u[jj] = un[jj];
            const int mlv = mlvn, blv = blvn;
            if (j0 + NB < 128) {
                mlvn = __float_as_int(MLOC[bh * 128 + j0 + NB + (F.lane & (NB - 1))]); blvn = __float_as_int(BLAST[bh * 128 + j0 + NB + (F.lane & (NB - 1))]);
#pragma unroll
                for (int jj = 0; jj < NB; ++jj) un[jj] = __builtin_nontemporal_load(U32 + (size_t)(bh * 128 + j0 + NB + jj) * 8192 + e2);
            }
#pragma unroll
            for (int jj = 0; jj < NB; ++jj) {
                const int unit = bh * 128 + j0 + jj; const size_t idx = (size_t)unit * 8192 + e2;
                C32[idx] = pk2(c0, c1);
                if (e2 == 0) MPREV[unit] = m;
                const float ml = __int_as_float(__builtin_amdgcn_readlane(mlv, jj)), bl = __int_as_float(__builtin_amdgcn_readlane(blv, jj));
                const float mn = fmaxf(bl + m, ml); const float wp = __expf(bl + m - mn), wsn = __expf(ml - mn);
                c0 = wp * c0 + wsn * bflo(u[jj]); c1 = wp * c1 + wsn * bfhi(u[jj]);
                m = mn;
            }
        }
    }
    for (int g2 = blockIdx.x * (NWAVES * 64) + F.tid; g2 < 16 * 64; g2 += F.G * NWAVES * 64) {
        const int bh = __builtin_amdgcn_readfirstlane(g2 >> 6), e2 = g2 & 63;
        float m = 0.f, n0 = 0.f, n1 = 0.f;
        f32x2_t nun[NB];
        int mlvn = __float_as_int(MLOC[bh * 128 + (F.lane & (NB - 1))]), blvn = __float_as_int(BLAST[bh * 128 + (F.lane & (NB - 1))]);
#pragma unroll
        for (int jj = 0; jj < NB; ++jj) nun[jj] = *(const f32x2_t*)(NU + (size_t)(bh * 128 + jj) * 128 + 2 * e2);
#pragma unroll 1
        for (int j0 = 0; j0 < 128; j0 += NB) {
            f32x2_t nu[NB];
#pragma unroll
            for (int jj = 0; jj < NB; ++jj) nu[jj] = nun[jj];
            const int mlv = mlvn, blv = blvn;
            if (j0 + NB < 128) {
                mlvn = __float_as_int(MLOC[bh * 128 + j0 + NB + (F.lane & (NB - 1))]); blvn = __float_as_int(BLAST[bh * 128 + j0 + NB + (F.lane & (NB - 1))]);
#pragma unroll
                for (int jj = 0; jj < NB; ++jj) nun[jj] = *(const f32x2_t*)(NU + (size_t)(bh * 128 + j0 + NB + jj) * 128 + 2 * e2);
            }
#pragma unroll
            for (int jj = 0; jj < NB; ++jj) {
                const int unit = bh * 128 + j0 + jj;
                *(f32x2_t*)(NPREV + (size_t)unit * 128 + 2 * e2) = (f32x2_t){n0, n1};
                const float ml = __int_as_float(__builtin_amdgcn_readlane(mlv, jj)), bl = __int_as_float(__builtin_amdgcn_readlane(blv, jj));
                const float mn = fmaxf(bl + m, ml); const float wp = __expf(bl + m - mn), wsn = __expf(ml - mn);
                n0 = wp * n0 + wsn * nu[jj][0]; n1 = wp * n1 + wsn * nu[jj][1];
                m = mn;
            }
        }
    }
}
constexpr int MC_TS = 256, MC_TS2 = 144, MC_BUF = 16896;
static_assert(64 * MC_TS <= MC_BUF && 64 * MC_TS2 <= MC_BUF && 8192 + 8 * MC_BUF <= LDSCTL_OFF, "mlstm_C LDS map");
__device__ __forceinline__ void mlstm_C(const Frame& F, const bf16* Z, const bf16* ZT, const float* GIF, const bf16* CT, const float* NPREV, const float* MPREV, bf16* YC) {
    const int lane = F.lane, w = F.wave, c = lane & 31, hl = lane >> 5;
    LAS float* wsc = (LAS float*)(F.lds + RING_OFF + w * 1024);
    LAS unsigned char* tb_ = F.lds + RING_OFF + 8192 + w * MC_BUF;
    unsigned swo[8];
#pragma unroll
    for (int ks = 0; ks < 8; ++ks) swo[ks] = (unsigned)c * 256u + ((unsigned)((2 * ks) ^ (hl ^ (c & 15))) << 4);
#define MC_STAGE256(srcv, pitchv, coffv) do { const char* s_ = (const char*)(srcv); unsigned lo_ = (unsigned)(lane >> 4) * (unsigned)(pitchv) + (unsigned)(lane & 15) * 16u + (unsigned)(coffv); \
        asm volatile("" : "+v"(lo_));     \
        _Pragma("unroll") for (int hb_ = 0; hb_ < 4; ++hb_) { v4u t_[4]; \
            _Pragma("unroll") for (int i_ = 0; i_ < 4; ++i_) t_[i_] = *(const v4u*)(s_ + (lo_ + (unsigned)(4 * (4 * hb_ + i_)) * (unsigned)(pitchv))); \
            _Pragma("unroll") for (int i_ = 0; i_ < 4; ++i_) { const int r_ = 4 * (4 * hb_ + i_) + (lane >> 4); *(LAS v4u*)(tb_ + r_ * MC_TS + (((lane & 15) ^ (r_ & 15)) << 4)) = t_[i_]; } \
            asm volatile("" ::: "memory"); } } while (0)
#define MC_STAGE128(srcv, pitchv, coffv) do { const char* s_ = (const char*)(srcv); unsigned lo_ = (unsigned)(lane >> 3) * (unsigned)(pitchv) + (unsigned)(lane & 7) * 16u + (unsigned)(coffv); \
        asm volatile("" : "+v"(lo_)); \
        _Pragma("unroll") for (int hb_ = 0; hb_ < 2; ++hb_) { v4u t_[4]; \
            _Pragma("unroll") for (int i_ = 0; i_ < 4; ++i_) t_[i_] = *(const v4u*)(s_ + (lo_ + (unsigned)(8 * (4 * hb_ + i_)) * (unsigned)(pitchv))); \
            _Pragma("unroll") for (int i_ = 0; i_ < 4; ++i_) { const int r_ = 8 * (4 * hb_ + i_) + (lane >> 3); *(LAS v4u*)(tb_ + r_ * MC_TS2 + (lane & 7) * 16) = t_[i_]; } \
            asm volatile("" ::: "memory"); } } while (0)
    for (int unit = blockIdx.x * NWAVES + w; unit < 2048; unit += F.G * NWAVES) {
        const int bh = unit >> 7, j = unit & 127, b = bh >> 2, h = bh & 3; const size_t t0 = (size_t)b * SEQ_ + 64 * j;
        { const float fg = GIF[(t0 + lane) * 8 + 4 + h], ig = GIF[(t0 + lane) * 8 + h];
          const float mprev = MPREV[unit];
          const float bcum = wave_scan_add(logsig(fg), lane);
          const float cs = ig - bcum; const float cmax = wave_scan_max(cs, lane);
          const float Mt = fmaxf(mprev, cmax);
          wsc[lane] = cs; wsc[64 + lane] = Mt; wsc[128 + lane] = __expf(mprev - Mt); wsc[192 + lane] = __expf(-(bcum + Mt)); }
        const bf16* uQ = Z + t0 * ZC_ + h * 128;
        const bf16* uV = ZT + (size_t)(h * 128) * T_ + t0;
        const bf16* uC = CT + (size_t)unit * 16384;
        const float* uN = NPREV + (size_t)unit * 128;
        bf16* uY = YC + t0 * D_ + h * 128;
        MC_STAGE256(uQ, ZC_ * 2, 1024);
        LDS_WAIT();
        bf16x8 qf[2][8];
#pragma unroll
        for (int tb = 0; tb < 2; ++tb)
#pragma unroll
            for (int ks = 0; ks < 8; ++ks) qf[tb][ks] = *(const LAS bf16x8*)(tb_ + swo[ks] + tb * 8192);
        LDS_WAIT();
        MC_STAGE256(uQ, ZC_ * 2, 0);
        LDS_WAIT();
        bf16x8 pf[2][2][2];
#pragma unroll
        for (int tb = 0; tb < 2; ++tb) {
            const int t = 32 * tb + c;
            const float Mt_c = wsc[64 + t], dec_c = wsc[128 + t], em_c = wsc[192 + t];
            float dsum = 0.f;
#pragma unroll
            for (int sb = 0; sb < 2; ++sb) {
                pf[tb][sb][0] = (bf16x8){}; pf[tb][sb][1] = (bf16x8){};
                if (sb <= tb) {
                    f32x16 sacc = {};
#pragma unroll
                    for (int ks = 0; ks < 8; ++ks) sacc = MFMA32(*(const LAS bf16x8*)(tb_ + swo[ks] + sb * 8192), qf[tb][ks], sacc);
                    float pv[16];
#pragma unroll
                    for (int g4 = 0; g4 < 4; ++g4) { const int s0 = 32 * sb + 8 * g4 + 4 * hl; const f32x4 cs4 = *(const LAS f32x4*)(wsc + s0);
#pragma unroll
                        for (int e = 0; e < 4; ++e) { const float v = (s0 + e <= t) ? sacc[4 * g4 + e] * __expf(cs4[e] - Mt_c) : 0.f; pv[4 * g4 + e] = v; dsum += v; } }
#pragma unroll
                    for (int ss = 0; ss < 2; ++ss) pf[tb][sb][ss] = pack8(pv[8 * ss], pv[8 * ss + 1], pv[8 * ss + 2], pv[8 * ss + 3], pv[8 * ss + 4], pv[8 * ss + 5], pv[8 * ss + 6], pv[8 * ss + 7]);
                }
            }
            dsum += __shfl_xor(dsum, 32);
            float qn = 0.f;
            { const unsigned no = 32 * hl;
#pragma unroll
              for (int ks = 0; ks < 8; ++ks) { const f32x4 n0 = *(const f32x4*)((const char*)uN + no + 64 * ks), n1 = *(const f32x4*)((const char*)uN + no + 64 * ks + 16);
                  qn += bfs(qf[tb][ks][0]) * n0[0] + bfs(qf[tb][ks][1]) * n0[1] + bfs(qf[tb][ks][2]) * n0[2] + bfs(qf[tb][ks][3]) * n0[3] + bfs(qf[tb][ks][4]) * n1[0] + bfs(qf[tb][ks][5]) * n1[1] + bfs(qf[tb][ks][6]) * n1[2] + bfs(qf[tb][ks][7]) * n1[3];
                  if ((ks & 3) == 3) asm volatile("" ::: "memory"); } }
            qn += __shfl_xor(qn, 32);
            const float den = dsum + dec_c * qn; const float inv_t = 1.0f / fmaxf(fabsf(den), em_c);
            if (hl == 0) wsc[192 + t] = inv_t;
        }
        LDS_WAIT();
#pragma unroll 1
        for (int dq = 0; dq < 4; ++dq) {
            { const char* s_ = (const char*)(uC + (size_t)dq * 32 * 128); unsigned lo_ = (unsigned)(lane >> 4) * 256u + (unsigned)(lane & 15) * 16u; asm volatile("" : "+v"(lo_));
#pragma unroll
              for (int hb_ = 0; hb_ < 2; ++hb_) { v4u t_[4];
#pragma unroll
                  for (int i_ = 0; i_ < 4; ++i_) t_[i_] = *(const v4u*)(s_ + (lo_ + (unsigned)(4 * (4 * hb_ + i_)) * 256u));
#pragma unroll
                  for (int i_ = 0; i_ < 4; ++i_) { const int r_ = 4 * (4 * hb_ + i_) + (lane >> 4); *(LAS v4u*)(tb_ + r_ * MC_TS + (((lane & 15) ^ (r_ & 15)) << 4)) = t_[i_]; }
                  asm volatile("" ::: "memory"); } }
            LDS_WAIT();
            f32x16 acc[2] = {{}, {}};
#pragma unroll
            for (int ks = 0; ks < 8; ++ks) { const bf16x8 cf = *(const LAS bf16x8*)(tb_ + swo[ks]); acc[0] = MFMA32(cf, qf[0][ks], acc[0]); acc[1] = MFMA32(cf, qf[1][ks], acc[1]); }
#pragma unroll
            for (int tb = 0; tb < 2; ++tb) acc[tb] = acc[tb] * wsc[128 + 32 * tb + c];
            LDS_WAIT();
            { const char* s_ = (const char*)(uV + (size_t)dq * 32 * T_); unsigned lo_ = (unsigned)(lane >> 3) * (unsigned)(T_ * 2) + (unsigned)(lane & 7) * 16u; asm volatile("" : "+v"(lo_));
              v4u t_[4];
#pragma unroll
              for (int i_ = 0; i_ < 4; ++i_) t_[i_] = *(const v4u*)(s_ + (lo_ + (unsigned)(8 * i_) * (unsigned)(T_ * 2)));
#pragma unroll
              for (int i_ = 0; i_ < 4; ++i_) { const int r_ = 8 * i_ + (lane >> 3); *(LAS v4u*)(tb_ + r_ * MC_TS2 + (lane & 7) * 16) = t_[i_]; }
              asm volatile("" ::: "memory"); }
            LDS_WAIT();
#pragma unroll
            for (int sb = 0; sb < 2; ++sb)
#pragma unroll
                for (int ss = 0; ss < 2; ++ss) { const LAS unsigned char* vp = tb_ + c * MC_TS2 + 64 * sb + 32 * ss + 8 * hl;
                    const s16x4 va = *(const LAS s16x4*)vp, vb = *(const LAS s16x4*)(vp + 16); const bf16x8 vf = (bf16x8){va[0], va[1], va[2], va[3], vb[0], vb[1], vb[2], vb[3]};
                    if (sb == 0) acc[0] = MFMA32(vf, pf[0][0][ss], acc[0]);
                    acc[1] = MFMA32(vf, pf[1][sb][ss], acc[1]); }
            LDS_WAIT();
            { const char* s_ = (const char*)uQ; unsigned lo_ = (unsigned)(lane >> 2) * (unsigned)(ZC_ * 2) + (unsigned)(lane & 3) * 16u + 2048u + 64u * dq; asm volatile("" : "+v"(lo_));
              v4u t_[4];
#pragma unroll
              for (int i_ = 0; i_ < 4; ++i_) t_[i_] = *(const v4u*)(s_ + (lo_ + (unsigned)(16 * i_) * (unsigned)(ZC_ * 2)));
#pragma unroll
              for (int i_ = 0; i_ < 4; ++i_) { const int r_ = 16 * i_ + (lane >> 2); *(LAS v4u*)(tb_ + r_ * 80 + (lane & 3) * 16) = t_[i_]; }
              asm volatile("" ::: "memory"); }
            LDS_WAIT();
#pragma unroll
            for (int tb = 0; tb < 2; ++tb) { const float inv_t = wsc[192 + 32 * tb + c];
#pragma unroll
                for (int g4 = 0; g4 < 4; ++g4) { LAS unsigned char* op = tb_ + (32 * tb + c) * 80 + 16 * g4 + 8 * hl;
                    const v2u og = *(const LAS v2u*)op; float y[4]; const float o4[4] = {bflo(og.x), bfhi(og.x), bflo(og.y), bfhi(og.y)};
#pragma unroll
                    for (int e = 0; e < 4; ++e) y[e] = fsigmoid(o4[e]) * (acc[tb][4 * g4 + e] * inv_t);
                    v2u o; o.x = pk2(y[0], y[1]); o.y = pk2(y[2], y[3]); *(LAS v2u*)op = o; } }
            LDS_WAIT();
            { unsigned yo_ = (unsigned)(lane >> 2) * (D_ * 2) + (unsigned)(lane & 3) * 16u + 64u * dq; asm volatile("" : "+v"(yo_));
#pragma unroll
              for (int i_ = 0; i_ < 4; ++i_) { const int r_ = 16 * i_ + (lane >> 2); const v4u v = *(const LAS v4u*)(tb_ + r_ * 80 + (lane & 3) * 16);
                  *(v4u*)((char*)uY + (yo_ + (unsigned)(16 * i_) * (D_ * 2))) = v; } }
            LDS_WAIT();
        }
    }
#undef MC_STAGE256
#undef MC_STAGE128
}

__device__ __forceinline__ void rg_A(const Frame& F, const bf16* Z, const float* conv_w, const float* conv_b, const bf16* RGW, const float* rg_ba, const float* rg_bx, const float* SP,
                                     float* ACH, float* HCH, unsigned* AU) {
    constexpr int XS = 136;
    const int lane = F.lane, w = F.wave, c = lane & 31, hl = lane >> 5;
    LAS bf16* XC = (LAS bf16*)(F.lds + RING_OFF + w * 17920);
    for (int task = blockIdx.x * NWAVES + w; task < 2048; task += F.G * NWAVES) {
        const int n = task & 3, cj = (task >> 2) & 127, b = task >> 9; const size_t row0 = (size_t)b * SEQ_ + 64 * cj;
        {
            const int cg = lane & 15, tq = lane >> 4, ch = 128 * n + 8 * cg;
            float cw[4][8], cb[8];
#pragma unroll
            for (int e = 0; e < 8; ++e) { cb[e] = conv_b[ch + e]; cw[0][e] = conv_w[ch + e]; cw[1][e] = conv_w[512 + ch + e]; cw[2][e] = conv_w[1024 + ch + e]; cw[3][e] = conv_w[1536 + ch + e]; }
            bf16x8 rin[19];
#pragma unroll
            for (int i = 0; i < 19; ++i) { const int tt = 16 * tq - 3 + i; rin[i] = (bf16x8){}; if (64 * cj + tt >= 0) rin[i] = ldg8(Z + (size_t)((long)row0 + tt) * ZC_ + 1536 + ch); }
#pragma unroll
            for (int i = 0; i < 16; ++i) { float o[8];
#pragma unroll
                for (int e = 0; e < 8; ++e) o[e] = cb[e] + cw[0][e] * bfs(rin[i][e]) + cw[1][e] * bfs(rin[i + 1][e]) + cw[2][e] * bfs(rin[i + 2][e]) + cw[3][e] * bfs(rin[i + 3][e]);
                v4u pw; pw.x = pk2(o[0], o[1]); pw.y = pk2(o[2], o[3]); pw.z = pk2(o[4], o[5]); pw.w = pk2(o[6], o[7]);
                *(LAS v4u*)(XC + (16 * tq + i) * XS + 8 * cg) = pw; }
        }
        LDS_WAIT();
#pragma unroll 1
        for (int dblk = 0; dblk < 4; ++dblk) {
            const int chl = 32 * dblk + c, chg = 128 * n + chl;
            f32x16 accA[2] = {{}, {}}, accX[2] = {{}, {}};
            { const bf16* wa = RGW + ((size_t)n * 128 + chl) * 128 + 8 * hl; const bf16* wx = wa + 65536;
              const LAS bf16* xa = XC + c * XS + 8 * hl;
#pragma unroll
              for (int ks = 0; ks < 8; ++ks) { const bf16x8 fa = ldg8(wa + 16 * ks), fx = ldg8(wx + 16 * ks);
#pragma unroll
                  for (int tb = 0; tb < 2; ++tb) { const bf16x8 af = *(const LAS bf16x8*)(xa + 32 * tb * XS + 16 * ks); accA[tb] = MFMA32(af, fa, accA[tb]); accX[tb] = MFMA32(af, fx, accX[tb]); } } }
            const float ba_c = rg_ba[chg], bx_c = rg_bx[chg], sp_c = SP[chg];
            float Ps[8], Hs[8];
#pragma unroll
            for (int tb = 0; tb < 2; ++tb)
#pragma unroll
                for (int g4 = 0; g4 < 4; ++g4) { float P = 1.f, H = 0.f;
#pragma unroll
                    for (int e = 0; e < 4; ++e) { const int r = 4 * g4 + e, t = 32 * tb + 8 * g4 + 4 * hl + e;
                        const float ra = fsigmoid(accA[tb][r] + ba_c), ri = fsigmoid(accX[tb][r] + bx_c); const float la = -ra * sp_c; const float av = __expf(la);
                        const float x2 = 2.f * la; const float om = (x2 > -0.02f) ? -x2 * (1.f + x2 * (0.5f + x2 * (1.f / 6.f))) : (1.f - av * av);
                        const float xcv = __uint_as_float(((unsigned)XC[t * XS + chl]) << 16);
                        const float uv = __builtin_amdgcn_sqrtf(om) * ri * xcv;
                        P *= av; H = av * H + uv;
                        AU[(row0 + t) * 512 + chg] = pk2(1.f - av, uv); }
                    Ps[4 * tb + g4] = P; Hs[4 * tb + g4] = H; }
            float Po[8], Ho[8];
#pragma unroll
            for (int i = 0; i < 8; ++i) { Po[i] = __shfl_xor(Ps[i], 32); Ho[i] = __shfl_xor(Hs[i], 32); }
            float carry = 0.f, AP = 1.f;
#pragma unroll
            for (int i = 0; i < 8; ++i) {
                const float P0 = hl == 0 ? Ps[i] : Po[i], H0 = hl == 0 ? Hs[i] : Ho[i], P1 = hl == 0 ? Po[i] : Ps[i], H1 = hl == 0 ? Ho[i] : Hs[i];
                carry = P0 * carry + H0; carry = P1 * carry + H1; AP *= P0 * P1; }
            if (hl == 0) { ACH[((size_t)b * 128 + cj) * 512 + chg] = AP; HCH[((size_t)b * 128 + cj) * 512 + chg] = carry; }
        }
        LDS_WAIT();
    }
}
__device__ __forceinline__ void rg_B(const Frame& F, const float* ACH, const float* HCH, float* HIN) {
    const int g = (F.G - 1 - (int)blockIdx.x) * (NWAVES * 64) + F.tid;
    if (g < 16384) {
        const int sc = g >> 3, p = g & 7, b = sc >> 9, ch = sc & 511;
        float a[16], h[16];
#pragma unroll
        for (int i = 0; i < 16; ++i) { const size_t idx = ((size_t)b * 128 + 16 * p + i) * 512 + ch; a[i] = ACH[idx]; h[i] = HCH[idx]; }
        float Ap = 1.f, Hp = 0.f;
#pragma unroll
        for (int i = 0; i < 16; ++i) { Hp = a[i] * Hp + h[i]; Ap *= a[i]; }
        float As = Ap, Hs = Hp;
#pragma unroll
        for (int o = 1; o < 8; o <<= 1) { const float Ao = __shfl_up(As, o, 8), Ho = __shfl_up(Hs, o, 8); if (p >= o) { Hs = As * Ho + Hs; As = As * Ao; } }
        float Hin = __shfl_up(Hs, 1, 8); if (p == 0) Hin = 0.f;
#pragma unroll
        for (int i = 0; i < 16; ++i) { const size_t idx = ((size_t)b * 128 + 16 * p + i) * 512 + ch; HIN[idx] = Hin; Hin = a[i] * Hin + h[i]; }
    }
}
__device__ __forceinline__ void rg_C(const Frame& F, const bf16* Z, const unsigned* AU, const float* HIN, bf16* YC) {
    const int lane = F.lane;
    for (int task = blockIdx.x * NWAVES + F.wave; task < 2048; task += F.G * NWAVES) {
        const int cg = task & 3, cj = (task >> 2) & 127, b = task >> 9; const size_t row0 = (size_t)b * SEQ_ + 64 * cj; const int ch = 128 * cg + 2 * lane;
        const float* hp = HIN + ((size_t)b * 128 + cj) * 512 + ch; float h0 = hp[0], h1 = hp[1];
        v2u aun[16]; unsigned ryn[16];
#pragma unroll
        for (int i = 0; i < 16; ++i) { aun[i] = *(const v2u*)(AU + (row0 + i) * 512 + ch); ryn[i] = *(const unsigned*)(Z + (row0 + i) * ZC_ + 2048 + ch); }
#pragma unroll 1
        for (int t0 = 0; t0 < 64; t0 += 16) {
            v2u au[16]; unsigned ry[16];
#pragma unroll
            for (int i = 0; i < 16; ++i) { au[i] = aun[i]; ry[i] = ryn[i]; }
            if (t0 + 16 < 64) {
#pragma unroll
                for (int i = 0; i < 16; ++i) { aun[i] = *(const v2u*)(AU + (row0 + t0 + 16 + i) * 512 + ch); ryn[i] = *(const unsigned*)(Z + (row0 + t0 + 16 + i) * ZC_ + 2048 + ch); }
            }
#pragma unroll
            for (int i = 0; i < 16; ++i) { h0 = (1.f - bflo(au[i].x)) * h0 + bfhi(au[i].x); h1 = (1.f - bflo(au[i].y)) * h1 + bfhi(au[i].y);
                const float r0 = bflo(ry[i]), r1 = bfhi(ry[i]);
                const float g0 = r0 * fsigmoid(1.5957691216057308f * (r0 + 0.044715f * r0 * r0 * r0)), g1 = r1 * fsigmoid(1.5957691216057308f * (r1 + 0.044715f * r1 * r1 * r1));
                *(unsigned*)(YC + (row0 + t0 + i) * D_ + 512 + ch) = pk2(g0 * h0, g1 * h1); }
        }
    }
}

constexpr int SK_STRIDE = 144, SV_STRIDE = 528, SBUF_V = 36864, SBUF = 36864 + 33792;
static_assert(2 * SBUF <= LDSCTL_OFF && MISC_OFF + 128 <= LDS_BYTES, "LDS map");
__device__ __forceinline__ void swa_phase(const Frame& F, const bf16* QK, const bf16* VT, const float* sinks, bf16* O) {
    const int lane = F.lane, w = F.wave, c = lane & 31, hl = lane >> 5, tid = F.tid;
    LAS unsigned char* lb = F.lds + RING_OFF;
    const int nun = (1024 - (int)blockIdx.x + F.G - 1) / F.G;
    v4u sk[4], sv[4];
#define SW_LOAD(uiv) do { const int un_ = (int)blockIdx.x + (uiv) * F.G, b_ = un_ >> 8, kvh_ = (un_ >> 6) & 3, j_ = un_ & 63; const long k0_ = (long)b_ * SEQ_ + 128 * (j_ - 1); \
        _Pragma("unroll") for (int q_ = 0; q_ < 4; ++q_) { const int p_ = tid + 512 * q_; const int kr_ = p_ >> 3; const int vk_ = (p_ & 31) * 8; \
            sk[q_] = (j_ > 0 || kr_ >= 128) ? *(const v4u*)(QK + (size_t)(k0_ + kr_) * QKC_ + 1024 + kvh_ * 64 + (p_ & 7) * 8) : (v4u){0u, 0u, 0u, 0u}; \
            sv[q_] = (j_ > 0 || kr_ >= 128) ? *(const v4u*)(QK + (size_t)(k0_ + kr_) * QKC_ + 1280 + kvh_ * 64 + (p_ & 7) * 8) : (v4u){0u, 0u, 0u, 0u}; (void)vk_; } } while (0)
#define SW_STORE(uiv) do { LAS unsigned char* bf_ = lb + ((uiv) & 1) * SBUF; \
        _Pragma("unroll") for (int q_ = 0; q_ < 4; ++q_) { const int p_ = tid + 512 * q_; *(LAS v4u*)(bf_ + (p_ >> 3) * SK_STRIDE + (p_ & 7) * 16) = sk[q_]; { const int kr2_ = p_ >> 3; const int kp_ = (kr2_ & ~15) + 8 * ((kr2_ >> 2) & 1) + 4 * ((kr2_ >> 3) & 1) + (kr2_ & 3);     \
              LAS bf16* vd_ = (LAS bf16*)(bf_ + SBUF_V + ((p_ & 7) * 8) * SV_STRIDE + kp_ * 2);     \
              vd_[0] = (bf16)(sv[q_].x & 0xffffu); vd_[SV_STRIDE / 2] = (bf16)(sv[q_].x >> 16); vd_[2 * (SV_STRIDE / 2)] = (bf16)(sv[q_].y & 0xffffu); vd_[3 * (SV_STRIDE / 2)] = (bf16)(sv[q_].y >> 16); \
              vd_[4 * (SV_STRIDE / 2)] = (bf16)(sv[q_].z & 0xffffu); vd_[5 * (SV_STRIDE / 2)] = (bf16)(sv[q_].z >> 16); vd_[6 * (SV_STRIDE / 2)] = (bf16)(sv[q_].w & 0xffffu); vd_[7 * (SV_STRIDE / 2)] = (bf16)(sv[q_].w >> 16); } } } while (0)
    if (nun <= 0) return;
    SW_LOAD(0); SW_STORE(0); __syncthreads();
    bf16x8 qn[4];
    { const int un0 = (int)blockIdx.x, b0 = un0 >> 8, kvh0 = (un0 >> 6) & 3, j0 = un0 & 63; const size_t row0_ = (size_t)b0 * SEQ_ + 128 * j0 + 64 * (w & 1) + c;
#pragma unroll
      for (int ks = 0; ks < 4; ++ks) qn[ks] = ldg8(QK + row0_ * QKC_ + (kvh0 * 4 + (w >> 1)) * 64 + 16 * ks + 8 * hl); }
    for (int ui = 0; ui < nun; ++ui) {
        const int unit = (int)blockIdx.x + ui * F.G;
        const int b = unit >> 8, kvh = (unit >> 6) & 3, j = unit & 63; const int head = kvh * 4 + (w >> 1); const float sink2 = sinks[head] * 1.4426950408889634f;
        if (ui + 1 < nun) SW_LOAD(ui + 1);
        const LAS unsigned char* kbuf = lb + (ui & 1) * SBUF + c * SK_STRIDE + 16 * hl; const LAS unsigned char* vbuf = lb + (ui & 1) * SBUF + SBUF_V + c * SV_STRIDE + 16 * hl;
#pragma unroll 1
        for (int qb2 = 0; qb2 < 2; ++qb2) {
            const int qo = 64 * (w & 1) + 32 * qb2, q0 = 128 * j + qo; const size_t row = (size_t)b * SEQ_ + q0 + c;
            bf16x8 qf[4];
#pragma unroll
            for (int ks = 0; ks < 4; ++ks) qf[ks] = qn[ks];
            {
                const int un2 = (qb2 == 0) ? unit : ((ui + 1 < nun) ? unit + F.G : unit); const int b2 = un2 >> 8, kvh2 = (un2 >> 6) & 3, j2 = un2 & 63;
                const size_t row2 = (size_t)b2 * SEQ_ + 128 * j2 + 64 * (w & 1) + ((qb2 == 0) ? 32 : 0) + c;
#pragma unroll
                for (int ks = 0; ks < 4; ++ks) qn[ks] = ldg8(QK + row2 * QKC_ + (kvh2 * 4 + (w >> 1)) * 64 + 16 * ks + 8 * hl); }
            const int lb0 = qo >> 5;
            const int i0 = (j == 0 && lb0 < 4) ? 4 - lb0 : 0;
            f32x16 o[2] = {{}, {}}; float sum = 0.f;
#pragma unroll
            for (int i = 0; i < 5; ++i) {
                if (i >= i0) {
                    f32x16 sc = {};
#pragma unroll
                    for (int ks = 0; ks < 4; ++ks) sc = MFMA32(*(const LAS bf16x8*)(kbuf + (lb0 + i) * 32 * SK_STRIDE + 32 * ks), qf[ks], sc);
                    float pe[16];
#pragma unroll
                    for (int r = 0; r < 16; ++r) { const int kk = (r & 3) + 8 * (r >> 2) + 4 * hl; float pp = __builtin_amdgcn_exp2f(__builtin_amdgcn_fmed3f(sc[r], -3.0e38f, 80.f));
                        if (i == 0) pp = kk > c ? pp : 0.f;
                        if (i == 4) pp = kk <= c ? pp : 0.f;
                        pe[r] = pp; sum += pp; }
#pragma unroll
                    for (int ss = 0; ss < 2; ++ss) { const bf16x8 pf = pack8(pe[8 * ss], pe[8 * ss + 1], pe[8 * ss + 2], pe[8 * ss + 3], pe[8 * ss + 4], pe[8 * ss + 5], pe[8 * ss + 6], pe[8 * ss + 7]);
#pragma unroll
                        for (int db = 0; db < 2; ++db) o[db] = MFMA32(*(const LAS bf16x8*)(vbuf + db * 32 * SV_STRIDE + 64 * (lb0 + i) + 32 * ss), pf, o[db]); }
                }
            }
            sum += __shfl_xor(sum, 32); const float inv = 1.0f / (sum + __builtin_amdgcn_exp2f(sink2));
            bf16* orow = O + row * D_ + head * 64 + 4 * hl;
#pragma unroll
            for (int db = 0; db < 2; ++db)
#pragma unroll
                for (int g4 = 0; g4 < 4; ++g4) { v2u ov; ov.x = pk2(o[db][4 * g4] * inv, o[db][4 * g4 + 1] * inv); ov.y = pk2(o[db][4 * g4 + 2] * inv, o[db][4 * g4 + 3] * inv); *(v2u*)(orow + 32 * db + 8 * g4) = ov; }
        }
        if (ui + 1 < nun) SW_STORE(ui + 1);
        __syncthreads();
    }
#undef SW_LOAD
#undef SW_STORE
}

#define GEMM_PLAIN(Aptr, Btptr, Mv, Nv, Kv, Optr, ldcv, scalev, ACTv, rsv, csv) do { \
        pg8::Gemm g_{(const pg8::bf16_t*)(Aptr), (const pg8::bf16_t*)(Btptr), (Mv), (Nv), (Kv), 0, 0}; pg8::StaticOrder S_; S_.init((Mv), (Nv), F.G, (int)blockIdx.x); \
        pg8::EpiOut<ACTv, true> E_{(pg8::bf16_t*)(Optr), (ldcv), (scalev), 0x7fffffff, (rsv), (csv), 0, (LAS float*)(F.lds + RING_BYTES + 4096)}; \
        pg8::gemm_phase<pg8::EpiOut<ACTv, true>, pg8::StaticOrder, true, true>(F.lds + RING_OFF, g_, S_, E_); } while (0)

__global__ void __launch_bounds__(NWAVES * 64, 2) mk_fwd(Args args) {
    extern __shared__ __attribute__((aligned(16))) unsigned char lds[];
    Frame F;
    F.lds = (LAS unsigned char*)lds; F.tid = threadIdx.x; F.lane = F.tid & 63; F.wave = __builtin_amdgcn_readfirstlane(F.tid >> 6); F.G = gridDim.x;
    { const int bx = blockIdx.x; const int vcu = (F.G % 8 == 0) ? (bx % 8) * (F.G / 8) + bx / 8 : bx; F.grp = vcu >> 2; F.mem = vcu & 3; }
    volatile LAS unsigned* MISC = (volatile LAS unsigned*)(F.lds + MISC_OFF);
    for (int u = F.tid; u < (LDS_BYTES - LDSCTL_OFF) / 4; u += NWAVES * 64) ((LAS unsigned*)(F.lds + LDSCTL_OFF))[u] = 0u;
    __syncthreads();
    unsigned char* ws = args.ws;
    gu32* ctl = (gu32*)(ws + WS_CTL);
    XcdBarrier bar; bar.bar = (unsigned*)(ctl + CW_BAR); bar.x = 0; bar.st = nullptr;
    if (N_LAUNCHES == 1) bar = xcd_barrier_post((unsigned*)(ctl + CW_BAR), MISC + 8);
#define GRID_BAR() do { if (N_LAUNCHES == 1) xcd_barrier(bar); } while (0)
    unsigned gsync_k = 0;
#define GROUP_SYNC() do { if (N_LAUNCHES == 1) { gsync_k += 4u; asm volatile("s_waitcnt vmcnt(0)" ::: "memory"); __syncthreads(); \
        if (F.tid == 0) { gu32* c_ = ctl + CW_GRP + 64 * F.grp; __hip_atomic_fetch_add(c_, 1u, RLX_AGENT); unsigned sp_ = 0; \
            while (__hip_atomic_load(c_, RLX_AGENT) < gsync_k) { __builtin_amdgcn_s_sleep(1); if (++sp_ > (1u << 22)) { __hip_atomic_store(ctl + CW_TMO, 1u, RLX_AGENT); break; } } \
            __builtin_amdgcn_fence(__ATOMIC_ACQUIRE, "agent"); asm volatile("s_waitcnt vmcnt(0)" ::: "memory"); } \
        __syncthreads(); } } while (0)
#define GSEAM(k) do { if (IN(k) && IN((k) + 1)) GROUP_SYNC(); } while (0)
    const int lo = args.ph_lo, hi = args.ph_hi;
#define IN(k) (lo <= (k) && (k) < hi)
#define PHASE(k, ...) do { if (IN(k)) { __VA_ARGS__; if ((REPMASK >> (k)) & 1u) { __VA_ARGS__; } } } while (0)
#define SEAM(k) do { if (IN(k) && IN((k) + 1)) GRID_BAR(); } while (0)

    const float* x = (const float*)args.in[0];
    const float* g_mix_pre = (const float*)args.in[16]; const float* g_mix_post = (const float*)args.in[17]; const float* g_x_pre = (const float*)args.in[18]; const float* g_x_post = (const float*)args.in[19];
    const float* g_ff_pre = (const float*)args.in[24]; const float* g_ff_post = (const float*)args.in[25];
    bf16* WIN = (bf16*)(ws + WS_WIN); bf16* WOUT = (bf16*)(ws + WS_WOUT); bf16* WQKV = (bf16*)(ws + WS_WQKV); bf16* WSO = (bf16*)(ws + WS_WSO); bf16* WXQ = (bf16*)(ws + WS_WXQ);
    bf16* WXO = (bf16*)(ws + WS_WXO); bf16* WFF1 = (bf16*)(ws + WS_WFF1); bf16* WFF2 = (bf16*)(ws + WS_WFF2); bf16* RGW = (bf16*)(ws + WS_RGW); bf16* KV = (bf16*)(ws + WS_KV);
    float* ROPE = (float*)(ws + WS_ROPE); float* GIF = (float*)(ws + WS_GIF); float* NU = (float*)(ws + WS_NU); float* NPREV = (float*)(ws + WS_NPREV);
    float* ACH = (float*)(ws + WS_ACH); float* HCH = (float*)(ws + WS_HCH); float* HIN = (float*)(ws + WS_HIN);
    float* MLOC = (float*)(ws + WS_SCAL); float* BLAST = MLOC + 2048; float* MPREV = MLOC + 4096; float* SP = MLOC + 6144;
    bf16* R1 = (bf16*)(ws + WS_R1); bf16* R2 = (bf16*)(ws + WS_R2); bf16* R3 = (bf16*)(ws + WS_R3); bf16* HB = (bf16*)(ws + WS_R4); bf16* MBW = (bf16*)(ws + WS_MB); bf16* VWBW = (bf16*)(ws + WS_VWB); float* RS = (float*)(ws + WS_RS); bf16* YD = (bf16*)args.out; bf16* PD = (bf16*)args.out + 33554432;     bf16* CTB = (bf16*)args.out; unsigned* AUB = (unsigned*)args.out + 16777216;

    if (IN(0)) p0_prologue(F, args);
    SEAM(0);
    if (IN(1)) {
        if (blockIdx.x < 64) {
            pg8::Gemm g{(const pg8::bf16_t*)(ws + WS_AALL), (const pg8::bf16_t*)(ws + WS_BTALL), 2048, 4096, 1024, 0, 0}; pg8::DiagOrder S{(int)blockIdx.x};
            pg8::EpiOut<0> E{(pg8::bf16_t*)KV, 2048, 1.0f, 7, nullptr, nullptr, 0};
            pg8::gemm_phase<pg8::EpiOut<0>, pg8::DiagOrder, true, true>(F.lds + RING_OFF, g, S, E);
        } else {
            norm_phase<0, true>(F, nullptr, nullptr, x, HB, RS, nullptr, g_mix_pre, 64, (const float*)args.in[3], (const float*)args.in[4], GIF);
        }
    }
    SEAM(1);
    PHASE(2, { const int kind = (int)blockIdx.x >> 7, c_ = (int)blockIdx.x & 127, q_ = c_ & 3, h_ = (c_ >> 2) & 3, b_ = (c_ >> 4) & 3, l_ = c_ >> 6;
               const bf16* kvp = KV + (size_t)(l_ * 1024 + b_ * 256) * 2048 + h_ * 256; const bf16* wqp = WXQ + (size_t)l_ * 1048576 + (size_t)q_ * 262144 + h_ * 256; const bf16* wop = WXO + (size_t)l_ * 1048576 + (size_t)q_ * 262144 + h_ * 256;
               pg8::Gemm g{(const pg8::bf16_t*)(kind == 0 ? kvp : wop), (const pg8::bf16_t*)(kind == 0 ? wqp : kvp + 1024), 256, 256, 256, kind == 0 ? 2048 : 1024, kind == 0 ? 1024 : 2048}; pg8::OneUnit S;
               pg8::EpiFold E{(pg8::bf16_t*)((kind == 0 ? MBW : VWBW) + (size_t)(l_ * 4 + b_) * 1048576 + (kind == 0 ? (size_t)(h_ * 256) * 1024 + q_ * 256 : (size_t)(q_ * 256) * 1024 + h_ * 256))};
               if (blockIdx.x < 256) pg8::gemm_phase<pg8::EpiFold, pg8::OneUnit, true, true>(F.lds + RING_OFF, g, S, E); }
        GEMM_PLAIN(HB, WIN + (size_t)512 * 1024, T_, ZC_, 1024, R2, ZC_, 1.0f, 0, RS, nullptr); GEMM_PLAIN(WIN, HB, 512, T_, 1024, R3, T_, 1.0f, 0, nullptr, RS));
    SEAM(2);
    PHASE(3, { if (F.wave & 4) { rg_A(F, R2, (const float*)args.in[5], (const float*)args.in[6], RGW, (const float*)args.in[8], (const float*)args.in[10], SP, ACH, HCH, AUB); mlstm_A(F, R2, R3, GIF, R1, NU, MLOC, BLAST); }
               else { mlstm_A(F, R2, R3, GIF, R1, NU, MLOC, BLAST); rg_A(F, R2, (const float*)args.in[5], (const float*)args.in[6], RGW, (const float*)args.in[8], (const float*)args.in[10], SP, ACH, HCH, AUB); }
               __syncthreads(); });
    SEAM(3);
    PHASE(4, mlstm_B(F, R1, NU, MLOC, BLAST, CTB, NPREV, MPREV); rg_B(F, ACH, HCH, HIN));
    SEAM(4);
    PHASE(5, mlstm_C(F, R2, R3, GIF, CTB, NPREV, MPREV, R1); rg_C(F, R2, AUB, HIN, R1));
    SEAM(5);
#define GEMM_GROUP(Aptr, ldav, Btptr, Kv, Optr, ldcv, perv, batchedv, ACTv, rsv) do { \
        pg8::Gemm g_{(const pg8::bf16_t*)(Aptr), (const pg8::bf16_t*)(Btptr), T_, 1024 * (perv), (Kv), (ldav), 0}; pg8::GroupOrder S_{F.grp, F.mem, (perv), (batchedv)}; \
        pg8::EpiOut<ACTv, (ACTv) == 2> E_{(pg8::bf16_t*)(Optr), (ldcv), 1.0f, 0x7fffffff, (rsv), nullptr, 1, (LAS float*)(F.lds + RING_BYTES + 4096)}; \
        pg8::gemm_phase<pg8::EpiOut<ACTv, (ACTv) == 2>, pg8::GroupOrder, true, true>(F.lds + RING_OFF, g_, S_, E_); } while (0)
    PHASE(6, GEMM_GROUP(R1, 0, WOUT, 1024, YD, 1024, 1, 0, 0, nullptr));
    GSEAM(6);
    if (IN(7)) norm_phase<1, false, true>(F, YD, g_mix_post, HB, HB, RS, nullptr, nullptr, 0, nullptr, nullptr, nullptr, 1024);
    GSEAM(7);
#define SHARED_PART(L, base) do { \
    PHASE((base) + 0, { pg8::Gemm g{(const pg8::bf16_t*)HB, (const pg8::bf16_t*)(MBW + (size_t)(L) * 4194304), T_, 1024, 1024, 0, 0}; pg8::GroupOrder S{F.grp, F.mem, 1, 1}; \
        pg8::EpiSoftmax E{(pg8::bf16_t*)PD, 1024, RS, 0.0625f * 1.4426950408889634f, (LAS float*)(F.lds + RING_BYTES)}; \
        pg8::gemm_phase<pg8::EpiSoftmax, pg8::GroupOrder, true, true>(F.lds + RING_OFF, g, S, E); }); \
    GSEAM((base) + 0); \
    PHASE((base) + 1, GEMM_GROUP(PD, 0, VWBW + (size_t)(L) * 4194304, 1024, YD, 1024, 1, 1, 0, nullptr)); \
    GSEAM((base) + 1); \
    if (IN((base) + 2)) norm_phase<1, false, true>(F, YD, g_x_post + (L) * 1024, HB, HB, RS, nullptr, nullptr, 0, nullptr, nullptr, nullptr, 1024); \
    GSEAM((base) + 2); \
    PHASE((base) + 3, GEMM_GROUP(HB, 0, WFF1 + (size_t)(L) * 4194304, 1024, R2, FF_, 4, 0, 2, RS)); \
    GSEAM((base) + 3); \
    PHASE((base) + 4, GEMM_GROUP(R2, 0, WFF2 + (size_t)(L) * 4194304, FF_, ((L) == 1 ? R1 : YD), 1024, 1, 0, 0, nullptr)); \
    if ((L) == 1) SEAM((base) + 4); else GSEAM((base) + 4); } while (0)
    SHARED_PART(0, 8);
    if (IN(13)) norm_phase<1, false, true>(F, YD, g_ff_post, HB, HB, RS, nullptr, nullptr, 0, nullptr, nullptr, nullptr, 1024);
    SEAM(13);
    PHASE(14, { pg8::Gemm g{(const pg8::bf16_t*)HB, (const pg8::bf16_t*)WQKV, T_, QKC_, 1024, 0, 0}; pg8::StaticOrder S; S.init(T_, QKC_, F.G, (int)blockIdx.x);
          pg8::EpiRope E{(pg8::bf16_t*)R2, QKC_, ROPE, 1024, 0.125f * 1.4426950408889634f, RS};
          pg8::gemm_phase<pg8::EpiRope, pg8::StaticOrder, true, true>(F.lds + RING_OFF, g, S, E); });
    SEAM(14);
    PHASE(15, swa_phase(F, R2, R3, (const float*)args.in[14], R1));
    SEAM(15);
    PHASE(16, GEMM_GROUP(R1, 0, WSO, 1024, YD, 1024, 1, 0, 0, nullptr));
    GSEAM(16);
    if (IN(17)) norm_phase<1, false, true>(F, YD, g_mix_post + 1024, HB, HB, RS, nullptr, nullptr, 0, nullptr, nullptr, nullptr, 1024);
    GSEAM(17);
    SHARED_PART(1, 18);
    if (IN(23)) norm_phase<2, false, true>(F, R1, g_ff_post + 1024, HB, nullptr, nullptr, args.out, nullptr, 0, nullptr, nullptr, nullptr, 1024);
#if RUN_PHASES < 8
    if (lo == RUN_PHASES) { for (size_t i = (size_t)blockIdx.x * 512 + F.tid; i < (size_t)T_ * D_ / 4; i += (size_t)F.G * 512) {
        f32x4 o_;
        if (DBG_F32) { o_ = (i < (size_t)DBG_F32 / 4) ? ((const f32x4*)(ws + DBG_SRC))[i] : (f32x4){0.f, 0.f, 0.f, 0.f}; }
        else { const v2u w_ = ((const v2u*)(ws + DBG_SRC))[i]; o_ = (f32x4){bflo(w_.x), bfhi(w_.x), bflo(w_.y), bfhi(w_.y)}; }
        if (DBG_SAN) { for (int e_ = 0; e_ < 4; ++e_) if (!(fabsf(o_[e_]) < 1e30f)) o_[e_] = 777.f; }
        ((f32x4*)args.out)[i] = o_; } }
#endif
#undef IN
#undef SEAM
}

extern "C" void kernel_launch(void* const* d_in, const int* in_sizes, int n_in, void* d_out, int out_size, void* d_ws, size_t ws_size, hipStream_t stream) {
    static int grid = 0;
    if (grid == 0) {
        if (n_in != 28 || in_sizes[0] != T_ * D_ || out_size != T_ * D_ || ws_size < WS_END) { fprintf(stderr, "kernel_launch: unexpected shapes: n_in %d in0 %d out %d ws %zu (need %zu)\n", n_in, n_in > 0 ? in_sizes[0] : -1, out_size, ws_size, (size_t)WS_END); grid = -1; return; }
        int dev = 0, cus = 0, per_cu = 0;
        if (hipGetDevice(&dev) != hipSuccess || hipDeviceGetAttribute(&cus, hipDeviceAttributeMultiprocessorCount, dev) != hipSuccess) { grid = -1; return; }
        if (hipFuncSetAttribute((const void*)mk_fwd, hipFuncAttributeMaxDynamicSharedMemorySize, LDS_BYTES) != hipSuccess) { fprintf(stderr, "kernel_launch: hipFuncSetAttribute failed\n"); grid = -1; return; }
        if (hipOccupancyMaxActiveBlocksPerMultiprocessor(&per_cu, (const void*)mk_fwd, NWAVES * 64, LDS_BYTES) != hipSuccess || per_cu < 1) fprintf(stderr, "kernel_launch: occupancy query reports %d\n", per_cu);
        (void)hipGetLastError();
        grid = cus;
        if (grid < 128) { fprintf(stderr, "kernel_launch: %d CUs: too few\n", grid); grid = -1; return; }
    }
    if (grid < 0) return;
    if (hipMemsetAsync((char*)d_ws + WS_CTL, 0, CTL_ZERO_BYTES, stream) != hipSuccess) return;
    Args a{};
    for (int i = 0; i < 28; ++i) a.in[i] = d_in[i];
    a.out = (float*)d_out; a.ws = (unsigned char*)d_ws;
    for (int li = 0; li < (N_LAUNCHES == 1 ? 1 : RUN_PHASES + (RUN_PHASES < 8 ? 1 : 0)); ++li) {
        if (N_LAUNCHES == 1) { a.ph_lo = 0; a.ph_hi = RUN_PHASES; } else { a.ph_lo = li; a.ph_hi = (li == RUN_PHASES) ? li : li + 1; }
        hipLaunchKernelGGL(mk_fwd, dim3(grid), dim3(NWAVES * 64), LDS_BYTES, stream, a);
        const hipError_t le = hipPeekAtLastError();
        if (le != hipSuccess) { fprintf(stderr, "kernel_launch: launch %d failed: %s\n", li, hipGetErrorName(le)); break; }
    }
}
```

```cpp
#include <hip/hip_runtime.h>
#include <cstdio>
#include <cstdint>
#include <cmath>
#ifndef NRR_SET
#define NRR_SET 1
#endif
namespace pg8 {
#define PG8_LAS __attribute__((address_space(3)))
typedef unsigned short bf16_t;
typedef short bf16x8 __attribute__((ext_vector_type(8)));
typedef float f32x4 __attribute__((ext_vector_type(4)));
typedef unsigned u32x4 __attribute__((ext_vector_type(4)));
constexpr int BM = 256, BK = 64, HALF = 128, HTB = HALF * BK * 2  , STAGE_BYTES = 8 * HTB, NXCD = 8, WGM = 8;

__host__ __device__ __forceinline__ int lds_byte(int r, int c) { const int st = (r >> 4) * 2 + (c >> 5), rr = r & 15, cc = c & 31, ob = rr * 64 + cc * 2; return st * 1024 + (ob ^ (((ob >> 9) & 1) << 5)); }
__host__ __device__ __forceinline__ void stage_rc(int b, int& R, int& C) { const int st = b / 1024, sb = b % 1024, swz = sb ^ (((sb >> 9) & 1) << 5); R = (st >> 1) * 16 + swz / 64; C = (st & 1) * 32 + (swz % 64) / 2; }
__host__ __device__ __forceinline__ int perm32(int rho) { const int n = rho >> 4, i = rho & 15; return 8 * (i >> 2) + 4 * n + (i & 3); }

struct Unit { int pm, pn; };
struct Gemm { const bf16_t* A; const bf16_t* Bt; int M, N, K; int lda, ldb; };

struct StaticOrder {
    int nM, nN, nwg, G, c;
    __host__ __device__ void init(int M, int N, int G_, int c_) { nM = M / BM; nN = N / BM; nwg = nM * nN; G = G_; c = c_; }
    __host__ __device__ bool next(int i, Unit& u) const {
        const long L = (long)i * G + c; if (L >= nwg) return false;
        int wgid = (int)L; { const int q = nwg / NXCD, r = nwg % NXCD, xcd = wgid % NXCD, off = wgid / NXCD; wgid = (xcd < r ? xcd * (q + 1) : r * (q + 1) + (xcd - r) * q) + off; }
        const int nig = WGM * nN, gid = wgid / nig, fm = gid * WGM, gsz = (nM - fm) < WGM ? (nM - fm) : WGM;
        u.pm = fm + ((wgid % nig) % gsz); u.pn = (wgid % nig) / gsz; return true;
    }
    __device__ __forceinline__ void a_ready(const Unit&) const {}
    __device__ __forceinline__ void done(const Unit&) const {}
    __device__ __forceinline__ size_t a_off(const Unit& u, size_t ta) const { return (size_t)u.pm * ta; }
    __device__ __forceinline__ size_t b_off(const Unit& u, size_t tb) const { return (size_t)u.pn * tb; }
};

__device__ __forceinline__ unsigned cvt_pk_bf16(float lo, float hi) { unsigned r; asm volatile("v_cvt_pk_bf16_f32 %0, %1, %2" : "=v"(r) : "v"(lo), "v"(hi)); return r; }
typedef float f32x2 __attribute__((ext_vector_type(2)));
__device__ __forceinline__ __amdgpu_buffer_rsrc_t wt_rsrc(const void* base) { return __builtin_amdgcn_make_buffer_rsrc(const_cast<void*>(base), 0, 0x7fffffff, 0x00020000); }
__device__ __forceinline__ void wt_store16(u32x4 v, __amdgpu_buffer_rsrc_t r, size_t byte_off) { __builtin_amdgcn_raw_buffer_store_b128(v, r, (int)(unsigned)byte_off, 0, 16); }
template <int ACT  , bool PF = false  > struct EpiOut {
    static constexpr bool PERM = true, AFTER_DRAIN = false, PREFETCH = PF;
    struct Pre {};
    bf16_t* O; int ldc; float scale; int pnmask; const float* rs; const float* cs; int wt; PG8_LAS float* rsl;
    __device__ __forceinline__ void prefetch(Pre&, const Unit& u, int wr, int wc, int fr, int fq) const {
        if (rs) { PG8_LAS float* slot = rsl + (wr * 4 + wc) * 128; const float* src = rs + u.pm * BM + wr * 64 + fq * 16 + fr;
            __builtin_amdgcn_global_load_lds((const unsigned*)src, (PG8_LAS unsigned*)slot, 4, 0, 0); __builtin_amdgcn_global_load_lds((const unsigned*)(src + HALF), (PG8_LAS unsigned*)(slot + 64), 4, 0, 0); }
    }
    __device__ __forceinline__ void operator()(const f32x4 (&acc)[2][2][4][2], const Unit& u, int wr, int wc, int fr, int fq) const { Pre p; with_pre(acc, p, u, wr, wc, fr, fq); }
    __device__ __forceinline__ void with_pre(const f32x4 (&acc)[2][2][4][2], const Pre&, const Unit& u, int wr, int wc, int fr, int fq) const {
        const int row0 = u.pm * BM + wr * 64 + fr; const int col0 = (u.pn & pnmask) * BM + wc * 32 + 8 * fq;
        const __amdgpu_buffer_rsrc_t wr_ = wt_rsrc(O);
        float r0[4], r1[4];
        if (PF) { const PG8_LAS float* slot = rsl + (wr * 4 + wc) * 128 + fr;
#pragma unroll
            for (int m = 0; m < 4; ++m) { r0[m] = rs ? slot[m * 16] : 1.f; r1[m] = rs ? slot[64 + m * 16] : 1.f; } }
        else {
#pragma unroll
            for (int m = 0; m < 4; ++m) { r0[m] = rs ? rs[row0 + m * 16] : 1.f; r1[m] = rs ? rs[row0 + HALF + m * 16] : 1.f; } }
        f32x4 cv[2][2];
#pragma unroll
        for (int bj = 0; bj < 2; ++bj) { cv[bj][0] = cs ? *(const f32x4*)(cs + col0 + bj * HALF) : (f32x4){1.f, 1.f, 1.f, 1.f}; cv[bj][1] = cs ? *(const f32x4*)(cs + col0 + bj * HALF + 4) : (f32x4){1.f, 1.f, 1.f, 1.f}; }
#pragma unroll
        for (int ai = 0; ai < 2; ++ai)
#pragma unroll
            for (int m = 0; m < 4; ++m) { const int row = row0 + ai * HALF + m * 16; bf16_t* rowp = O + (size_t)row * ldc + col0; const float sc = scale * (ai == 0 ? r0[m] : r1[m]);
#pragma unroll
                for (int bj = 0; bj < 2; ++bj) { f32x4 v0 = acc[ai][bj][m][0] * cv[bj][0], v1 = acc[ai][bj][m][1] * cv[bj][1];
                    if (ACT == 2) {
#pragma unroll
                        for (int e = 0; e < 4; ++e) { const float a = fmaxf(v0[e] * sc, 0.f), b = fmaxf(v1[e] * sc, 0.f); v0[e] = a * a; v1[e] = b * b; } }
                    else { v0 = v0 * sc; v1 = v1 * sc; }
                    u32x4 w; w.x = cvt_pk_bf16(v0[0], v0[1]); w.y = cvt_pk_bf16(v0[2], v0[3]); w.z = cvt_pk_bf16(v1[0], v1[1]); w.w = cvt_pk_bf16(v1[2], v1[3]);
                    if (wt) wt_store16(w, wr_, (size_t)((const char*)(rowp + bj * HALF) - (const char*)O)); else *(u32x4*)(rowp + bj * HALF) = w; } }
    }
};
struct EpiRope {
    static constexpr bool PERM = true, AFTER_DRAIN = false, PREFETCH = false;
    struct Pre {};
    bf16_t* O; int ldc; const float* cs; int qcols; float qscale; const float* rs;
    __device__ __forceinline__ void operator()(const f32x4 (&acc)[2][2][4][2], const Unit& u, int wr, int wc, int fr, int fq) const {
        const int row0 = u.pm * BM + wr * 64 + fr; const int col0 = u.pn * BM + wc * 32 + 8 * fq;
        const int i0 = (col0 & 63) >> 1;
#pragma unroll
        for (int ai = 0; ai < 2; ++ai) {
        float rsv[2][4]; f32x4 c01[2][4], c23[2][4];
#pragma unroll
            for (int m = 0; m < 4; ++m) { const int row = row0 + ai * HALF + m * 16; rsv[ai][m] = rs[row];
                const f32x4* cp = (const f32x4*)(cs + (size_t)row * 64 + i0 * 2); c01[ai][m] = cp[0]; c23[ai][m] = cp[1]; }
#pragma unroll
            for (int m = 0; m < 4; ++m) { const int row = row0 + ai * HALF + m * 16; bf16_t* rowp = O + (size_t)row * ldc + col0;
#pragma unroll
                for (int bj = 0; bj < 2; ++bj) { const int col = col0 + bj * HALF;
                    const f32x4 v0 = acc[ai][bj][m][0], v1 = acc[ai][bj][m][1]; const float sc = (col < qcols ? qscale : 1.f) * rsv[ai][m];
                    const f32x4 a01 = c01[ai][m], a23 = c23[ai][m];
                    f32x4 o0, o1;
                    if (col >= 1280) { o0 = v0; o1 = v1; } else {
                    o0[0] = v0[0] * a01[0] - v0[1] * a01[1]; o0[1] = v0[1] * a01[0] + v0[0] * a01[1]; o0[2] = v0[2] * a01[2] - v0[3] * a01[3]; o0[3] = v0[3] * a01[2] + v0[2] * a01[3];
                    o1[0] = v1[0] * a23[0] - v1[1] * a23[1]; o1[1] = v1[1] * a23[0] + v1[0] * a23[1]; o1[2] = v1[2] * a23[2] - v1[3] * a23[3]; o1[3] = v1[3] * a23[2] + v1[2] * a23[3]; }
                    o0 = o0 * sc; o1 = o1 * sc;
                    u32x4 w; w.x = cvt_pk_bf16(o0[0], o0[1]); w.y = cvt_pk_bf16(o0[2], o0[3]); w.z = cvt_pk_bf16(o1[0], o1[1]); w.w = cvt_pk_bf16(o1[2], o1[3]);
                    *(u32x4*)(rowp + bj * HALF) = w; } }
        }
    }
};
struct EpiOutKP {
    static constexpr bool PERM = true, AFTER_DRAIN = false, PREFETCH = false;
    struct Pre {};
    bf16_t* O; int ldc; int pnmask; int pm_from; const float* cs;
    __device__ __forceinline__ void operator()(const f32x4 (&acc)[2][2][4][2], const Unit& u, int wr, int wc, int fr, int fq) const {
        typedef unsigned u32x2 __attribute__((ext_vector_type(2)));
        const int row0 = u.pm * BM + wr * 64 + fr; const int col0 = (u.pn & pnmask) * BM + wc * 32 + 8 * fq; const bool kp = u.pm >= pm_from;
#pragma unroll
        for (int ai = 0; ai < 2; ++ai)
#pragma unroll
            for (int m = 0; m < 4; ++m) { bf16_t* rowp = O + (size_t)(row0 + ai * HALF + m * 16) * ldc;
#pragma unroll
                for (int bj = 0; bj < 2; ++bj) { const int col = col0 + bj * HALF; const f32x4 v0 = acc[ai][bj][m][0] * (cs ? *(const f32x4*)(cs + col) : (f32x4){1.f, 1.f, 1.f, 1.f}), v1 = acc[ai][bj][m][1] * (cs ? *(const f32x4*)(cs + col + 4) : (f32x4){1.f, 1.f, 1.f, 1.f});
                    u32x4 w; w.x = cvt_pk_bf16(v0[0], v0[1]); w.y = cvt_pk_bf16(v0[2], v0[3]); w.z = cvt_pk_bf16(v1[0], v1[1]); w.w = cvt_pk_bf16(v1[2], v1[3]);
                    if (kp) { const int p0 = (col & ~15) + 4 * ((col >> 3) & 1); *(u32x2*)(rowp + p0) = (u32x2){w.x, w.y}; *(u32x2*)(rowp + p0 + 8) = (u32x2){w.z, w.w}; }
                    else *(u32x4*)(rowp + col) = w; } }
    }
};
struct EpiSoftmax {
    static constexpr bool PERM = true, AFTER_DRAIN = false, PREFETCH = false;
    struct Pre {};
    bf16_t* O; int ldc; const float* rs; float qscale_log2e; PG8_LAS float* part;
    __device__ __forceinline__ void operator()(f32x4 (&acc)[2][2][4][2], const Unit& u, int wr, int wc, int fr, int fq) const {
        const int row0 = u.pm * BM + wr * 64 + fr; const int col0 = (u.pn & 3) * BM + wc * 32 + 8 * fq;
        const __amdgpu_buffer_rsrc_t wr_ = wt_rsrc(O);
        float rsv[2][4];
#pragma unroll
        for (int ai = 0; ai < 2; ++ai)
#pragma unroll
            for (int m = 0; m < 4; ++m) rsv[ai][m] = rs[row0 + ai * HALF + m * 16];
#pragma unroll
        for (int ai = 0; ai < 2; ++ai)
#pragma unroll
            for (int m = 0; m < 4; ++m) { const float sc = rsv[ai][m] * qscale_log2e; float ps = 0.f;
#pragma unroll
                for (int bj = 0; bj < 2; ++bj)
#pragma unroll
                    for (int n = 0; n < 2; ++n) { f32x4 v = acc[ai][bj][m][n] * sc;
#pragma unroll
                        for (int e = 0; e < 4; ++e) { v[e] = __builtin_amdgcn_exp2f(fminf(v[e], 80.f)); ps += v[e]; }
                        acc[ai][bj][m][n] = v; }
                ps += __shfl_xor(ps, 16); ps += __shfl_xor(ps, 32);
                if (fq == 0) part[(ai * HALF + wr * 64 + m * 16 + fr) * 4 + wc] = ps; }
        asm volatile("s_waitcnt lgkmcnt(0)" ::: "memory"); __builtin_amdgcn_s_barrier(); asm volatile("" ::: "memory");
#pragma unroll
        for (int ai = 0; ai < 2; ++ai)
#pragma unroll
            for (int m = 0; m < 4; ++m) { const f32x4 p4 = *(const PG8_LAS f32x4*)(part + (ai * HALF + wr * 64 + m * 16 + fr) * 4); const float inv = 1.0f / ((p4[0] + p4[1]) + (p4[2] + p4[3]));
                bf16_t* rowp = O + (size_t)(row0 + ai * HALF + m * 16) * ldc + col0;
#pragma unroll
                for (int bj = 0; bj < 2; ++bj) { const f32x4 v0 = acc[ai][bj][m][0] * inv, v1 = acc[ai][bj][m][1] * inv;
                    u32x4 w; w.x = cvt_pk_bf16(v0[0], v0[1]); w.y = cvt_pk_bf16(v0[2], v0[3]); w.z = cvt_pk_bf16(v1[0], v1[1]); w.w = cvt_pk_bf16(v1[2], v1[3]);
                    wt_store16(w, wr_, (size_t)((const char*)(rowp + bj * HALF) - (const char*)O)); } }
        asm volatile("s_waitcnt lgkmcnt(0)" ::: "memory");
    }
};
struct EpiFold {
    static constexpr bool PERM = true, AFTER_DRAIN = false, PREFETCH = false;
    struct Pre {};
    bf16_t* O;
    __device__ __forceinline__ void operator()(const f32x4 (&acc)[2][2][4][2], const Unit&, int wr, int wc, int fr, int fq) const {
        const int row0 = wr * 64 + fr, col0 = wc * 32 + 8 * fq;
#pragma unroll
        for (int ai = 0; ai < 2; ++ai)
#pragma unroll
            for (int m = 0; m < 4; ++m) { bf16_t* rowp = O + (size_t)(row0 + ai * HALF + m * 16) * 1024 + col0;
#pragma unroll
                for (int bj = 0; bj < 2; ++bj) { const f32x4 v0 = acc[ai][bj][m][0] * 1.0f, v1 = acc[ai][bj][m][1] * 1.0f;
                    u32x4 w; w.x = cvt_pk_bf16(v0[0], v0[1]); w.y = cvt_pk_bf16(v0[2], v0[3]); w.z = cvt_pk_bf16(v1[0], v1[1]); w.w = cvt_pk_bf16(v1[2], v1[3]);
                    *(u32x4*)(rowp + bj * HALF) = w; } }
    }
};
struct DiagOrder {
    int c;
    __device__ __forceinline__ bool next(int i, Unit& u) const { if (i > 0 || c >= 64) return false; const int l = c >> 5, r = c & 31; u.pm = 4 * l + (r >> 3); u.pn = 8 * l + (r & 7); return true; }
    __device__ __forceinline__ void a_ready(const Unit&) const {}
    __device__ __forceinline__ void done(const Unit&) const {}
    __device__ __forceinline__ size_t a_off(const Unit& u, size_t ta) const { return (size_t)u.pm * ta; }
    __device__ __forceinline__ size_t b_off(const Unit& u, size_t tb) const { return (size_t)u.pn * tb; }
};
struct BatchOrder {
    StaticOrder so;
    __device__ __forceinline__ bool next(int i, Unit& u) const { return so.next(i, u); }
    __device__ __forceinline__ void a_ready(const Unit&) const {}
    __device__ __forceinline__ void done(const Unit&) const {}
    __device__ __forceinline__ size_t a_off(const Unit& u, size_t ta) const { return (size_t)u.pm * ta; }
    __device__ __forceinline__ size_t b_off(const Unit& u, size_t tb) const { return (size_t)((u.pm >> 5) * 4 + u.pn) * tb; }
};
struct GroupOrder {
    int g, m, per, batched;
    __device__ __forceinline__ bool next(int i, Unit& u) const { if (i >= 2 * per) return false; const int p = i / per, j = i - p * per; u.pm = 2 * g + p; u.pn = m + 4 * j; return true; }
    __device__ __forceinline__ void a_ready(const Unit&) const {}
    __device__ __forceinline__ void done(const Unit&) const {}
    __device__ __forceinline__ size_t a_off(const Unit& u, size_t ta) const { return (size_t)u.pm * ta; }
    __device__ __forceinline__ size_t b_off(const Unit& u, size_t tb) const { return (size_t)((batched ? (u.pm >> 5) * 4 : 0) + u.pn) * tb; }
};
struct OneUnit {
    __device__ __forceinline__ bool next(int i, Unit& u) const { if (i > 0) return false; u.pm = 0; u.pn = 0; return true; }
    __device__ __forceinline__ void a_ready(const Unit&) const {}
    __device__ __forceinline__ void done(const Unit&) const {}
    __device__ __forceinline__ size_t a_off(const Unit&, size_t) const { return 0; }
    __device__ __forceinline__ size_t b_off(const Unit&, size_t) const { return 0; }
};

template <class Epi, class Sched, bool ALIGN_EPI = false, bool SP2 = false>
__device__ __forceinline__ void gemm_phase(PG8_LAS unsigned char* lds, const Gemm g, const Sched& S, const Epi& E) {
    const int tid = threadIdx.x, wid = __builtin_amdgcn_readfirstlane(tid >> 6), lane = tid & 63, wr = wid >> 2, wc = wid & 3, fr = lane & 15, fq = lane >> 4;
    const int K = g.K, nt = K / BK; const int lda = g.lda ? g.lda : K, ldb = g.ldb ? g.ldb : K;
    unsigned voffA[2], voffB[2];
#pragma unroll
    for (int i = 0; i < 2; ++i) { int R, C; stage_rc(tid * 16 + i * 8192, R, C); const int Rb = Epi::PERM ? ((R & ~31) + perm32(R & 31)) : R;
        voffA[i] = (unsigned)(R * lda + C) * 2u; voffB[i] = (unsigned)(Rb * ldb + C) * 2u; }
    const size_t kstep = (size_t)(BK * 2);
    const size_t hstepA = (size_t)HALF * lda * 2, hstepB = (size_t)HALF * ldb * 2;
    const size_t tstepA = 2 * hstepA, tstepB = 2 * hstepB;
    const unsigned ldsw = (unsigned)wid * 1024u;
    const int aoff = lds_byte(wr * 64 + fr, fq * 8), boff = lds_byte(wc * 32 + fr, fq * 8);
#define PG8_SA(b, h) (((b) * 2 + (h)) * HTB)
#define PG8_SB(b, h) ((4 + (b) * 2 + (h)) * HTB)
#define PG8_STAGE(bufoff, gbase, voff) do { _Pragma("unroll") for (int _i = 0; _i < 2; ++_i) \
        __builtin_amdgcn_global_load_lds((const unsigned*)((const char*)(gbase) + (voff)[_i]), (PG8_LAS unsigned*)(lds + (bufoff) + ldsw + _i * 8192), 16, 0, 0); } while (0)
#define PG8_LDA(dst, b, h) do { _Pragma("unroll") for (int m = 0; m < 4; ++m) _Pragma("unroll") for (int k = 0; k < 2; ++k) dst[m][k] = *(const PG8_LAS bf16x8*)(lds + PG8_SA(b, h) + aoff + m * 2048 + k * 1024); } while (0)
#define PG8_LDB(dst, b, h) do { _Pragma("unroll") for (int n = 0; n < 2; ++n) _Pragma("unroll") for (int k = 0; k < 2; ++k) dst[n][k] = *(const PG8_LAS bf16x8*)(lds + PG8_SB(b, h) + boff + n * 2048 + k * 1024); } while (0)
#define PG8_MMA(ai, bj, At, Bt) do { __builtin_amdgcn_s_setprio(1); _Pragma("unroll") for (int m = 0; m < 4; ++m) _Pragma("unroll") for (int n = 0; n < 2; ++n) _Pragma("unroll") for (int k = 0; k < 2; ++k) \
        acc[ai][bj][m][n] = __builtin_amdgcn_mfma_f32_16x16x32_bf16(Bt[n][k], At[m][k], acc[ai][bj][m][n], 0, 0, 0); __builtin_amdgcn_s_setprio(0); } while (0)
#define PG8_WAIT_V(n) asm volatile("s_waitcnt vmcnt(" #n ")" ::: "memory")
#define PG8_WAIT_L(n) asm volatile("s_waitcnt lgkmcnt(" #n ")" ::: "memory")
#define PG8_BAR __builtin_amdgcn_s_barrier()
#define PG8_SCHED __builtin_amdgcn_sched_barrier(0)
    Unit cur, nxt; int ui = 0;
    if (!S.next(0, cur)) return;
    typename Epi::Pre pre = {};
    f32x4 acc[2][2][4][2];
#pragma unroll
    for (int a = 0; a < 2; ++a)
#pragma unroll
        for (int b = 0; b < 2; ++b)
#pragma unroll
            for (int m = 0; m < 4; ++m)
#pragma unroll
                for (int n = 0; n < 2; ++n) acc[a][b][m][n] = (f32x4){0.f, 0.f, 0.f, 0.f};
    bf16x8 At[4][2], B0[2][2], B1[2][2];
    const char* cA = (const char*)g.A + S.a_off(cur, tstepA); const char* cB = (const char*)g.Bt + S.b_off(cur, tstepB);
    S.a_ready(cur);
    if constexpr (SP2) {
        PG8_STAGE(PG8_SB(0, 0), cB, voffB); PG8_STAGE(PG8_SB(0, 1), cB + hstepB, voffB); PG8_STAGE(PG8_SA(0, 0), cA, voffA); PG8_STAGE(PG8_SA(0, 1), cA + hstepA, voffA);
        if (wr == 1) PG8_BAR;
        PG8_WAIT_V(2); PG8_BAR;
        PG8_STAGE(PG8_SB(1, 0), cB + kstep, voffB); PG8_STAGE(PG8_SA(1, 0), cA + kstep, voffA); PG8_STAGE(PG8_SB(1, 1), cB + hstepB + kstep, voffB);
        PG8_WAIT_V(6); PG8_BAR;
    } else {
        PG8_STAGE(PG8_SB(0, 0), cB, voffB); PG8_STAGE(PG8_SA(0, 0), cA, voffA); PG8_STAGE(PG8_SB(0, 1), cB + hstepB, voffB); PG8_STAGE(PG8_SA(0, 1), cA + hstepA, voffA);
        if (wr == 1) PG8_BAR;
        PG8_WAIT_V(4); PG8_BAR;
        PG8_STAGE(PG8_SB(1, 0), cB + kstep, voffB); PG8_STAGE(PG8_SA(1, 0), cA + kstep, voffA); PG8_STAGE(PG8_SB(1, 1), cB + hstepB + kstep, voffB);
        PG8_WAIT_V(6); PG8_BAR;
    }
    for (;;) {
        const bool has_next = S.next(ui + 1, nxt);
        const char* nA = has_next ? (const char*)g.A + S.a_off(nxt, tstepA) : cA; const char* nB = has_next ? (const char*)g.Bt + S.b_off(nxt, tstepB) : cB;
        for (int t = 0; t < nt; t += 2) {
            const bool last = (t == nt - 2);
            const char* a1 = cA + (size_t)(t + 1) * kstep;
            const char* a2 = last ? nA : cA + (size_t)(t + 2) * kstep; const char* b2 = last ? nB : cB + (size_t)(t + 2) * kstep;
            const char* a3 = a2 + kstep; const char* b3 = b2 + kstep;
            if (last && has_next) S.a_ready(nxt);
            if constexpr (Epi::PREFETCH) { if (last) E.prefetch(pre, cur, wr, wc, fr, fq); }
            if constexpr (SP2) {
            PG8_LDB(B0, 0, 0); PG8_LDB(B1, 0, 1); PG8_SCHED; PG8_LDA(At, 0, 0); PG8_STAGE(PG8_SA(1, 1), a1 + hstepA, voffA);
            PG8_WAIT_V(8); PG8_WAIT_L(0); PG8_BAR; PG8_MMA(0, 0, At, B0); PG8_MMA(0, 1, At, B1); PG8_BAR; PG8_SCHED;
            PG8_LDA(At, 0, 1); PG8_STAGE(PG8_SB(0, 0), b2, voffB); PG8_STAGE(PG8_SB(0, 1), b2 + hstepB, voffB); PG8_STAGE(PG8_SA(0, 0), a2, voffA);
            PG8_WAIT_V(8); PG8_WAIT_L(0); PG8_BAR; PG8_MMA(1, 0, At, B0); PG8_MMA(1, 1, At, B1); PG8_BAR; PG8_SCHED;
            PG8_LDB(B0, 1, 0); PG8_LDB(B1, 1, 1); PG8_SCHED; PG8_LDA(At, 1, 0); PG8_STAGE(PG8_SA(0, 1), a2 + hstepA, voffA);
            PG8_WAIT_V(8); PG8_WAIT_L(0); PG8_BAR; PG8_MMA(0, 0, At, B0); PG8_MMA(0, 1, At, B1); PG8_BAR; PG8_SCHED;
            PG8_LDA(At, 1, 1); PG8_STAGE(PG8_SB(1, 0), b3, voffB); PG8_STAGE(PG8_SB(1, 1), b3 + hstepB, voffB); PG8_STAGE(PG8_SA(1, 0), a3, voffA);
            PG8_WAIT_V(8); PG8_WAIT_L(0); PG8_BAR; PG8_MMA(1, 0, At, B0); PG8_MMA(1, 1, At, B1); PG8_BAR; PG8_SCHED;
            } else {
            PG8_LDB(B0, 0, 0); PG8_SCHED; PG8_LDA(At, 0, 0); PG8_STAGE(PG8_SA(1, 1), a1 + hstepA, voffA);
            PG8_WAIT_L(8); PG8_BAR; PG8_WAIT_L(0); PG8_MMA(0, 0, At, B0); PG8_BAR; PG8_SCHED;
            PG8_LDB(B1, 0, 1); PG8_STAGE(PG8_SB(0, 0), b2, voffB);
            PG8_BAR; PG8_WAIT_L(0); PG8_MMA(0, 1, At, B1); PG8_BAR;
            PG8_LDA(At, 0, 1); PG8_STAGE(PG8_SA(0, 0), a2, voffA);
            PG8_BAR; PG8_WAIT_L(0); PG8_MMA(1, 0, At, B0); PG8_BAR; PG8_SCHED;
            PG8_STAGE(PG8_SB(0, 1), b2 + hstepB, voffB);
            PG8_WAIT_V(6); PG8_BAR; PG8_MMA(1, 1, At, B1); PG8_BAR;
            PG8_LDB(B0, 1, 0); PG8_SCHED; PG8_LDA(At, 1, 0); PG8_STAGE(PG8_SA(0, 1), a2 + hstepA, voffA);
            PG8_WAIT_L(8); PG8_BAR; PG8_WAIT_L(0); PG8_MMA(0, 0, At, B0); PG8_BAR; PG8_SCHED;
            PG8_LDB(B1, 1, 1); PG8_STAGE(PG8_SB(1, 0), b3, voffB);
            PG8_BAR; PG8_WAIT_L(0); PG8_MMA(0, 1, At, B1); PG8_BAR;
            PG8_LDA(At, 1, 1); PG8_STAGE(PG8_SA(1, 0), a3, voffA);
            PG8_BAR; PG8_WAIT_L(0); PG8_MMA(1, 0, At, B0); PG8_BAR; PG8_SCHED;
            PG8_STAGE(PG8_SB(1, 1), b3 + hstepB, voffB);
            PG8_WAIT_V(6); PG8_BAR; PG8_MMA(1, 1, At, B1); PG8_BAR;
            }
        }
        if constexpr (ALIGN_EPI) { if (wr == 0) PG8_BAR; }
        if constexpr (!Epi::AFTER_DRAIN) { if constexpr (Epi::PREFETCH) E.with_pre(acc, pre, cur, wr, wc, fr, fq); else E(acc, cur, wr, wc, fr, fq); S.done(cur); }
        if (!has_next) break;
#pragma unroll
        for (int a = 0; a < 2; ++a)
#pragma unroll
            for (int b = 0; b < 2; ++b)
#pragma unroll
                for (int m = 0; m < 4; ++m)
#pragma unroll
                    for (int n = 0; n < 2; ++n) acc[a][b][m][n] = (f32x4){0.f, 0.f, 0.f, 0.f};
        cur = nxt; cA = nA; cB = nB; ++ui;
        if constexpr (ALIGN_EPI) { if (wr == 1) PG8_BAR; }
    }
    PG8_WAIT_V(0);
    if constexpr (!ALIGN_EPI) { if (wr == 0) PG8_BAR; }
    PG8_BAR;
    if constexpr (Epi::AFTER_DRAIN) { E.fused(acc, cur, wr, wc, fr, fq, lds, wid, lane); S.done(cur); }
#undef PG8_SA
#undef PG8_SB
#undef PG8_STAGE
#undef PG8_LDA
#undef PG8_LDB
#undef PG8_MMA
#undef PG8_WAIT_V
#undef PG8_WAIT_L
#undef PG8_BAR
#undef PG8_SCHED
}
}

constexpr int NWAVES = 8;
constexpr int T_ = 32768, D_ = 1024, SEQ_ = 8192, NB_ = 4, FF_ = 4096, ZC_ = 2560, QKC_ = 1536, INC_ = 3080;
constexpr float EPS_ = 1e-6f;
#ifndef MK_N_LAUNCHES
#define MK_N_LAUNCHES 1
#ifndef RUN_PHASES
#define RUN_PHASES 24
#ifndef REPMASK
#define REPMASK 0u
#endif
#define DBG_SRC WS_R1
#define DBG_F32 0
#define DBG_SAN 0
#endif
#endif
constexpr int NPH = 24;
constexpr int N_LAUNCHES = MK_N_LAUNCHES;

constexpr size_t MiB = 1u << 20;
constexpr size_t WS_CTL = 0, CTL_ZERO_BYTES = 1 * MiB;
constexpr size_t WS_WIN = 2 * MiB;
constexpr size_t WS_WOUT = 8 * MiB;
constexpr size_t WS_WQKV = 10 * MiB;
constexpr size_t WS_WSO = 13 * MiB;
constexpr size_t WS_WXQ = 15 * MiB;
constexpr size_t WS_BTALL = 19 * MiB;
constexpr size_t WS_AALL = 27 * MiB;
constexpr size_t WS_WXO = 35 * MiB;
constexpr size_t WS_WFF1 = 39 * MiB;
constexpr size_t WS_WFF2 = 55 * MiB;
constexpr size_t WS_RGW = 71 * MiB;
constexpr size_t WS_KV = 72 * MiB;
constexpr size_t WS_ROPE = 80 * MiB;
constexpr size_t WS_GIF = 88 * MiB;
constexpr size_t WS_NU = 89 * MiB;
constexpr size_t WS_NPREV = 90 * MiB;
constexpr size_t WS_ACH = 91 * MiB;
constexpr size_t WS_HCH = 92 * MiB;
constexpr size_t WS_HIN = 93 * MiB;
constexpr size_t WS_SCAL = 94 * MiB;
constexpr size_t WS_RS = 95 * MiB;
constexpr size_t WS_R1 = 96 * MiB;
constexpr size_t WS_R2 = 160 * MiB;
constexpr size_t WS_R3 = 352 * MiB;
constexpr size_t WS_R4 = 416 * MiB;
constexpr size_t WS_MB = 480 * MiB;
constexpr size_t WS_VWB = 496 * MiB;
constexpr size_t WS_END = 512 * MiB;
constexpr int CW_TMO = 0, CW_CODE = 1, CW_BAR = 4096, CW_GRP = 32768;

constexpr int RING_OFF = 0, RING_BYTES = 131072;
constexpr int LDSCTL_OFF = 143360, MISC_OFF = LDSCTL_OFF + 320;
constexpr int LDS_BYTES = 147456;

#define GAS __attribute__((address_space(1)))
#define LAS __attribute__((address_space(3)))
typedef unsigned short bf16;
typedef unsigned v4u __attribute__((ext_vector_type(4)));
typedef unsigned v2u __attribute__((ext_vector_type(2)));
typedef float f32x4 __attribute__((ext_vector_type(4)));
typedef float f32x16 __attribute__((ext_vector_type(16)));
typedef short bf16x8 __attribute__((ext_vector_type(8)));
typedef short s16x4 __attribute__((ext_vector_type(4)));
typedef GAS unsigned gu32;
#define RLX_AGENT __ATOMIC_RELAXED, __HIP_MEMORY_SCOPE_AGENT
#define LDS_WAIT() asm volatile("s_waitcnt lgkmcnt(0)" ::: "memory")
#define VM_WAIT() asm volatile("s_waitcnt vmcnt(0)" ::: "memory")
#define MFMA32(a, b, c) __builtin_amdgcn_mfma_f32_32x32x16_bf16((a), (b), (c), 0, 0, 0)
typedef float f32x2_t __attribute__((ext_vector_type(2))); typedef __bf16 bf16x2_t __attribute__((ext_vector_type(2)));
__device__ __forceinline__ unsigned pk2(float lo, float hi) { const f32x2_t v = {lo, hi}; const bf16x2_t b = __builtin_convertvector(v, bf16x2_t); return __builtin_bit_cast(unsigned, b); }
__device__ __forceinline__ float bflo(unsigned w) { return __uint_as_float(w << 16); }
__device__ __forceinline__ float bfhi(unsigned w) { return __uint_as_float(w & 0xffff0000u); }
__device__ __forceinline__ float bfs(short s) { return __uint_as_float(((unsigned)(unsigned short)s) << 16); }
__device__ __forceinline__ float fsigmoid(float x) { return __builtin_amdgcn_rcpf(1.0f + __expf(-x)); }
__device__ __forceinline__ float logsig(float x) { return fminf(x, 0.f) - log1pf(__expf(-fabsf(x))); }
__device__ __forceinline__ float wave_sum(float v) {
    v += __int_as_float(__builtin_amdgcn_update_dpp(0, __float_as_int(v), 0xB1, 0xF, 0xF, false));
    v += __int_as_float(__builtin_amdgcn_update_dpp(0, __float_as_int(v), 0x4E, 0xF, 0xF, false));
    v += __int_as_float(__builtin_amdgcn_update_dpp(0, __float_as_int(v), 0x141, 0xF, 0xF, false));
    v += __int_as_float(__builtin_amdgcn_update_dpp(0, __float_as_int(v), 0x140, 0xF, 0xF, false));
    const int iv = __float_as_int(v);
    const float r0 = __int_as_float(__builtin_amdgcn_readlane(iv, 0)), r1 = __int_as_float(__builtin_amdgcn_readlane(iv, 16)), r2 = __int_as_float(__builtin_amdgcn_readlane(iv, 32)), r3 = __int_as_float(__builtin_amdgcn_readlane(iv, 48));
    return (r0 + r1) + (r2 + r3);
}
__device__ __forceinline__ float wave_max(float v) {
#pragma unroll
    for (int o = 1; o < 64; o <<= 1) v = fmaxf(v, __shfl_xor(v, o));
    return v;
}
__device__ __forceinline__ float wave_scan_add(float v, int lane) {
#pragma unroll
    for (int o = 1; o < 64; o <<= 1) { const float t = __shfl_up(v, o); if (lane >= o) v += t; }
    return v;
}
__device__ __forceinline__ float wave_scan_max(float v, int lane) {
#pragma unroll
    for (int o = 1; o < 64; o <<= 1) { const float t = __shfl_up(v, o); if (lane >= o) v = fmaxf(v, t); }
    return v;
}
__device__ __forceinline__ bf16x8 ldg8(const bf16* p) { return *(const bf16x8*)p; }
__device__ __forceinline__ bf16x8 ld_perm8(const bf16* p) { const s16x4 a = *(const s16x4*)p, b = *(const s16x4*)(p + 8); return (bf16x8){a[0], a[1], a[2], a[3], b[0], b[1], b[2], b[3]}; }
__device__ __forceinline__ bf16x8 pack8(float a0, float a1, float a2, float a3, float a4, float a5, float a6, float a7) {
    v4u w; w.x = pk2(a0, a1); w.y = pk2(a2, a3); w.z = pk2(a4, a5); w.w = pk2(a6, a7); return __builtin_bit_cast(bf16x8, w); }

struct Args { const void* in[28]; float* out; unsigned char* ws; int ph_lo, ph_hi; };
#define XB_TMO      128
#define XB_XCNT(j)  (256  + 64 * (j))
#define XB_XSUB(j)  (1280 + 64 * (j))
#define XB_XGEN(j)  (2304 + 64 * (j))
#define XB_TOP      3328
#define XB_TOPGEN   3392
#define XCD_BAR_WORDS 3456
#define XB_SPIN_CAP (1u << 18)

__device__ __forceinline__ unsigned xb_ld(unsigned* p)              { return __hip_atomic_load(p, __ATOMIC_RELAXED, __HIP_MEMORY_SCOPE_AGENT); }
__device__ __forceinline__ unsigned xb_add(unsigned* p, unsigned v) { return __hip_atomic_fetch_add(p, v, __ATOMIC_RELAXED, __HIP_MEMORY_SCOPE_AGENT); }
__device__ __forceinline__ unsigned xb_xcc_id() { return (unsigned)__builtin_amdgcn_s_getreg((3 << 11) | 20) & 0xFu; }
#define XB_SPIN(cond, bar) do { unsigned _sp = 0; while (cond) { __builtin_amdgcn_s_sleep(1); \
    if ((++_sp & 255u) == 0u) { if (xb_ld(&(bar)[XB_TMO])) break; if (_sp > XB_SPIN_CAP) { atomicAdd(&(bar)[XB_TMO], 1u); break; } } } } while (0)

struct XcdBarrier {
    unsigned* bar; unsigned x;
    volatile LAS unsigned* st;
};

__device__ __forceinline__ XcdBarrier xcd_barrier_post(unsigned* bar, volatile LAS unsigned* st) {
    XcdBarrier b; b.bar = bar; b.x = xb_xcc_id(); b.st = st;
    if (threadIdx.x == 0) (void)xb_add(&bar[XB_XCNT(b.x)], 1u);
    return b;
}
__device__ __forceinline__ void xcd_barrier_complete(unsigned* bar, unsigned x, unsigned& nloc, unsigned& nx) {
    const unsigned G = gridDim.x * gridDim.y * gridDim.z;
    unsigned sum, cnt, mine, sp = 0u;
    for (;;) {
        sum = 0u; cnt = 0u; mine = 0u;
#pragma unroll
        for (unsigned j = 0; j < 16; ++j) { const unsigned c = xb_ld(&bar[XB_XCNT(j)]); sum += c; cnt += (c > 0u) ? 1u : 0u; mine = (j == x) ? c : mine; }
        if (sum == G) break;
        __builtin_amdgcn_s_sleep(1);
        if ((++sp & 255u) == 0u) { if (xb_ld(&bar[XB_TMO])) break; if (sp > XB_SPIN_CAP) { atomicAdd(&bar[XB_TMO], 1u); break; } }
    }
    nloc = mine > 0u ? mine : 1u; nx = cnt > 0u ? cnt : 1u;
}

__device__ __forceinline__ void xcd_barrier(const XcdBarrier& b) {
    asm volatile("s_waitcnt vmcnt(0)" ::: "memory");
    __syncthreads();
    if (threadIdx.x == 0) {
        unsigned* bar = b.bar;
        __builtin_amdgcn_s_waitcnt(0);
        unsigned nloc = b.st[0], nx = b.st[1];
        if (nloc == 0u) { xcd_barrier_complete(bar, b.x, nloc, nx); b.st[0] = nloc; b.st[1] = nx; }
        const unsigned old = xb_add(&bar[XB_XSUB(b.x)], 1u);
        const unsigned gen = old / nloc;
        if (old + 1u == (gen + 1u) * nloc) {
            __builtin_amdgcn_fence(__ATOMIC_RELEASE, "agent");
            asm volatile("s_waitcnt vmcnt(0)" ::: "memory");
            const unsigned og = xb_add(&bar[XB_TOP], 1u);
            const unsigned tg = og / nx;
            if (og + 1u == (tg + 1u) * nx) xb_add(&bar[XB_TOPGEN], 1u);
            else XB_SPIN(xb_ld(&bar[XB_TOPGEN]) == tg, bar);
            __builtin_amdgcn_fence(__ATOMIC_ACQUIRE, "agent");
            xb_add(&bar[XB_XGEN(b.x)], 1u);
            asm volatile("s_waitcnt vmcnt(0)" ::: "memory");
        } else {
            XB_SPIN(xb_ld(&bar[XB_XGEN(b.x)]) == gen, bar);
            __builtin_amdgcn_fence(__ATOMIC_ACQUIRE, "agent");
            asm volatile("s_waitcnt vmcnt(0)" ::: "memory");
        }
    }
    __syncthreads();
}

struct Frame { LAS unsigned char* lds; int tid, lane, wave, G; int grp, mem; };

__device__ __forceinline__ int srccol(int kind, int n) {
    if (kind == 1) return n < 512 ? 1024 + n : (n < 1024 ? n : (n < 1536 ? n - 1024 : (n < 2048 ? n : n + 8)));
    if (kind == 2) { if (n >= 1280) return n; const int hd = n >> 6, p = n & 63; return hd * 64 + (p >> 1) + 32 * (p & 1); }
    return n;
}
__device__ __forceinline__ void p0_transpose_item(const float* W, int K, int N, int ndst, int col_off, int kind, bf16* WT, LAS float* scr, int item, int lane, const float* gk = nullptr) {
    const int nblk = ndst / 32, kb = item / nblk, nb = item % nblk, k0 = 64 * kb, n0 = 32 * nb;
    const int n = n0 + (lane & 31); const int sc = srccol(kind, n) + col_off;
    const float scale = (kind == 1 && n >= 512 && n < 1024) ? 0.08838834764831845f : 1.0f;
    float wv[32];
#pragma unroll
    for (int i = 0; i < 32; ++i) wv[i] = W[(size_t)(k0 + 2 * i + (lane >> 5)) * N + sc];
#pragma unroll
    for (int i = 0; i < 32; ++i) { const int kk = 2 * i + (lane >> 5); scr[kk * 33 + (lane & 31)] = wv[i] * (gk ? scale * gk[k0 + kk] : scale); }
    LDS_WAIT(); asm volatile("" ::: "memory");
    const int c = lane & 7;
#pragma unroll
    for (int j = 0; j < 4; ++j) { const int nn = (lane >> 3) + 8 * j; const LAS float* s = scr + (8 * c) * 33 + nn;
        v4u o; o.x = pk2(s[0 * 33], s[1 * 33]); o.y = pk2(s[2 * 33], s[3 * 33]); o.z = pk2(s[4 * 33], s[5 * 33]); o.w = pk2(s[6 * 33], s[7 * 33]);
        *(v4u*)(WT + (size_t)(n0 + nn) * K + k0 + 8 * c) = o; }
    LDS_WAIT(); asm volatile("" ::: "memory");
}
__device__ __forceinline__ void rms_row_to_bf16(const float* xrow, const float* g, bf16* o1, bf16* o2, int lane) {
    const f32x4* xr = (const f32x4*)xrow + lane; const f32x4* gr = (const f32x4*)g + lane;
    f32x4 v[4]; float s = 0.f;
#pragma unroll
    for (int j = 0; j < 4; ++j) { v[j] = xr[64 * j]; s += (v[j].x * v[j].x + v[j].y * v[j].y) + (v[j].z * v[j].z + v[j].w * v[j].w); }
    const float r = rsqrtf(wave_sum(s) * (1.f / 1024.f) + EPS_);
#pragma unroll
    for (int j = 0; j < 4; ++j) { const f32x4 gg = gr[64 * j]; v2u w; w.x = pk2(v[j].x * r * gg.x, v[j].y * r * gg.y); w.y = pk2(v[j].z * r * gg.z, v[j].w * r * gg.w);
        *((v2u*)o1 + lane + 64 * j) = w; *((v2u*)o2 + lane + 64 * j) = w; }
}

__device__ __forceinline__ void p0_prologue(const Frame& F, const Args& a) {
    unsigned char* ws = a.ws;
    LAS float* scr = (LAS float*)(F.lds + RING_OFF + F.wave * 16384);
    const int gw = blockIdx.x * NWAVES + F.wave, NGW = F.G * NWAVES;
    constexpr int I_SQ = 16 * 32, I_IN = 16 * 96, I_QKV = 16 * 48, I_FF1 = 16 * 128, I_FF2 = 64 * 32;
    constexpr int NITEMS = I_IN + I_SQ + I_QKV + I_SQ + 4 * I_SQ + 2 * I_SQ + 2 * I_FF1 + 2 * I_FF2;
    const float* w_in = (const float*)a.in[3]; const float* w_out = (const float*)a.in[12]; const float* w_qkv = (const float*)a.in[13]; const float* w_so = (const float*)a.in[15];
    const float* w_xq = (const float*)a.in[21]; const float* w_xkv = (const float*)a.in[22]; const float* w_xo = (const float*)a.in[23]; const float* w_ff1 = (const float*)a.in[26]; const float* w_ff2 = (const float*)a.in[27];
    for (int it = gw; it < NITEMS; it += NGW) {
        int r = it;
        if (r < I_IN) { p0_transpose_item(w_in, 1024, INC_, 3072, 0, 1, (bf16*)(ws + WS_WIN), scr, r, F.lane, (const float*)a.in[16]); continue; } r -= I_IN;
        if (r < I_SQ) { p0_transpose_item(w_out, 1024, 1024, 1024, 0, 0, (bf16*)(ws + WS_WOUT), scr, r, F.lane); continue; } r -= I_SQ;
        if (r < I_QKV) { p0_transpose_item(w_qkv, 1024, 1536, 1536, 0, 2, (bf16*)(ws + WS_WQKV), scr, r, F.lane, (const float*)a.in[16] + 1024); continue; } r -= I_QKV;
        if (r < I_SQ) { p0_transpose_item(w_so, 1024, 1024, 1024, 0, 0, (bf16*)(ws + WS_WSO), scr, r, F.lane); continue; } r -= I_SQ;
        if (r < 4 * I_SQ) { const int l = r / (2 * I_SQ); p0_transpose_item(w_xkv + (size_t)l * 2097152, 1024, 2048, 2048, 0, 0, (bf16*)(ws + WS_BTALL) + (size_t)l * 2097152, scr, r % (2 * I_SQ), F.lane); continue; } r -= 4 * I_SQ;
        if (r < 2 * I_SQ) { const int l = r / I_SQ; p0_transpose_item(w_xo + (size_t)l * 1048576, 1024, 1024, 1024, 0, 0, (bf16*)(ws + WS_WXO) + (size_t)l * 1048576, scr, r % I_SQ, F.lane); continue; } r -= 2 * I_SQ;
        if (r < 2 * I_FF1) { const int l = r / I_FF1; p0_transpose_item(w_ff1 + (size_t)l * 4194304, 1024, 4096, 4096, 0, 0, (bf16*)(ws + WS_WFF1) + (size_t)l * 4194304, scr, r % I_FF1, F.lane, (const float*)a.in[24] + l * 1024); continue; } r -= 2 * I_FF1;
        { const int l = r / I_FF2; p0_transpose_item(w_ff2 + (size_t)l * 4194304, 4096, 1024, 1024, 0, 0, (bf16*)(ws + WS_WFF2) + (size_t)l * 4194304, scr, r % I_FF2, F.lane); }
    }
    const int gt = blockIdx.x * (NWAVES * 64) + F.tid, NGT = F.G * NWAVES * 64;
    { const float* wa = (const float*)a.in[7]; const float* wx = (const float*)a.in[9]; bf16* o = (bf16*)(ws + WS_RGW);
      for (int i = gt; i < 2 * 65536; i += NGT) { const int which = i >> 16, e = i & 65535, n = e >> 14, d = (e >> 7) & 127, c = e & 127;
          const float v = (which ? wx : wa)[n * 16384 + c * 128 + d]; o[i] = (bf16)(pk2(v, 0.f) & 0xffffu); } }
    { const float* gx = (const float*)a.in[18]; bf16* o = (bf16*)(ws + WS_WXQ);
      for (int i0 = gt; i0 < 2 * 1048576 / 2; i0 += 8 * NGT) { float2 v[8]; float g[8];
#pragma unroll
          for (int u = 0; u < 8; ++u) { const int i = min(i0 + u * NGT, 1048575); v[u] = ((const float2*)w_xq)[i]; g[u] = gx[(i >> 19) * 1024 + ((i >> 9) & 1023)]; }
#pragma unroll
          for (int u = 0; u < 8; ++u) { const int i = i0 + u * NGT; if (i < 1048576) ((unsigned*)o)[i] = pk2(v[u].x * g[u], v[u].y * g[u]); } } }
    { const float* lam = (const float*)a.in[11]; float* sp = (float*)(ws + WS_SCAL) + 3 * 2048;
      for (int i = gt; i < 512; i += NGT) { const float x = -lam[i]; sp[i] = 8.0f * (fmaxf(x, 0.f) + log1pf(__expf(-fabsf(x)))); } }
    { const int* pos = (const int*)a.in[2]; float* cs = (float*)(ws + WS_ROPE);
      const float inv = (float)exp2(-(double)(gt & 31) * (13.287712379549449 / 32.0));
      for (int i0 = gt; i0 < T_ * 32; i0 += 8 * NGT) { int pv[8];
#pragma unroll
          for (int u = 0; u < 8; ++u) { const int i = min(i0 + u * NGT, T_ * 32 - 1); pv[u] = pos[i >> 5]; }
#pragma unroll
          for (int u = 0; u < 8; ++u) { const int i = i0 + u * NGT; if (i < T_ * 32) {
              const float ang = (float)pv[u] * inv;
              const double rev = (double)ang * 0.15915494309189535; const float fr = (float)(rev - floor(rev));
              *(float2*)(cs + 2 * i) = make_float2(__builtin_amdgcn_cosf(fr), __builtin_amdgcn_sinf(fr)); } } } }
    { const float* mem = (const float*)a.in[1]; const float* gm = (const float*)a.in[20];
      for (int m = gw; m < 2048; m += NGW) { const int l = m >> 10, row = m & 1023;
          bf16* mo = (bf16*)(ws + WS_AALL) + (size_t)l * 1048576 + (size_t)row * 1024; rms_row_to_bf16(mem + (size_t)row * 1024, gm + l * 1024, mo, mo, F.lane); } }
}

template <int MODE, bool HF32, bool GROUPED = false> __device__ __forceinline__ void norm_phase(const Frame& F, const bf16* y, const float* gpost, const void* hin, bf16* Hout, float* RSout, float* outf, const float* gpre,
                                                                           int wg0, const float* w_in, const float* b_if, float* gif, int ldy = 1024) {
    const int lane = F.lane; const int nwg = F.G - wg0; if ((int)blockIdx.x < wg0) return;
    const int gw = ((int)blockIdx.x - wg0) * NWAVES + F.wave, NGW = nwg * NWAVES;
    LAS float* wif = (LAS float*)(F.lds + RING_OFF);
    if (MODE == 0) { for (int i = F.tid; i < 8192; i += NWAVES * 64) { const int k = i >> 3, c = i & 7; wif[c * 1024 + k] = w_in[(size_t)k * INC_ + 2048 + c]; } __syncthreads(); }
    f32x4 wreg[8][4];
    if (MODE == 0) {
#pragma unroll
        for (int c = 0; c < 8; ++c)
#pragma unroll
            for (int hf = 0; hf < 2; ++hf) { wreg[c][2 * hf] = *(const LAS f32x4*)(wif + c * 1024 + 512 * hf + 8 * lane); wreg[c][2 * hf + 1] = *(const LAS f32x4*)(wif + c * 1024 + 512 * hf + 8 * lane + 4); } }
    float g[16];
#pragma unroll
    for (int hf = 0; hf < 2; ++hf)
#pragma unroll
        for (int e = 0; e < 8; ++e) g[8 * hf + e] = (MODE == 0) ? gpre[512 * hf + 8 * lane + e] : gpost[512 * hf + 8 * lane + e];
    const __amdgpu_buffer_rsrc_t hrs_ = __builtin_amdgcn_make_buffer_rsrc((void*)Hout, 0, 0x7fffffff, 0x00020000), rrs_ = __builtin_amdgcn_make_buffer_rsrc((void*)RSout, 0, 0x7fffffff, 0x00020000);
    constexpr int NRR = ((MODE != 0) && GROUPED && !HF32) ? NRR_SET : 2;
    constexpr int NST = 16 / NRR;
    const int r_begin = GROUPED ? 512 * F.grp + 128 * F.mem + F.wave : gw, r_end = GROUPED ? 512 * F.grp + 128 * F.mem + 128 : T_, r_step = GROUPED ? 8 * NRR : 2 * NGW, r_second = GROUPED ? 8 : NGW;
    const int rot = GROUPED ? ((4 * F.grp + F.mem) * 5) & (NST - 1) : 0;
    f32x4 nx[2][4];
    if (MODE == 0) {
#pragma unroll
        for (int rr = 0; rr < 2; ++rr) { const int row = r_begin + rr * r_second;
#pragma unroll
            for (int q = 0; q < 4; ++q) nx[rr][q] = (row < T_) ? *((const f32x4*)((const float*)hin + (size_t)row * 1024 + 512 * (q >> 1) + 8 * lane) + (q & 1)) : (f32x4){0.f, 0.f, 0.f, 0.f}; } }
    constexpr bool PIPE = (MODE != 0) && GROUPED && !HF32;
    v4u nyw[2][2], nhw[2][2];
    if constexpr (PIPE) {
#pragma unroll
        for (int rr = 0; rr < NRR; ++rr) { const int row = r_begin + 8 * NRR * (rot & (NST - 1)) + rr * r_second;
#pragma unroll
            for (int hf = 0; hf < 2; ++hf) { nyw[rr][hf] = *(const v4u*)(y + (size_t)row * ldy + 512 * hf + 8 * lane); nhw[rr][hf] = *(const v4u*)((const bf16*)hin + (size_t)row * 1024 + 512 * hf + 8 * lane); } } }
    for (int rowi = r_begin; rowi < r_end; rowi += r_step) {
        const int row0 = GROUPED ? r_begin + 8 * NRR * ((((rowi - r_begin) / (8 * NRR)) + rot) & (NST - 1)) : rowi;
        float hv[2][16], yv[2][16];
        v4u cyw[2][2], chw[2][2];
        if constexpr (PIPE) {
#pragma unroll
            for (int rr = 0; rr < NRR; ++rr)
#pragma unroll
                for (int hf = 0; hf < 2; ++hf) { cyw[rr][hf] = nyw[rr][hf]; chw[rr][hf] = nhw[rr][hf]; }
            if (rowi + r_step < r_end) { const int rown = r_begin + 8 * NRR * ((((rowi + r_step - r_begin) / (8 * NRR)) + rot) & (NST - 1));
#pragma unroll
                for (int rr = 0; rr < NRR; ++rr) { const int row = rown + rr * r_second;
#pragma unroll
                    for (int hf = 0; hf < 2; ++hf) { nyw[rr][hf] = *(const v4u*)(y + (size_t)row * ldy + 512 * hf + 8 * lane); nhw[rr][hf] = *(const v4u*)((const bf16*)hin + (size_t)row * 1024 + 512 * hf + 8 * lane); } } } }
        if (MODE == 0) {
#pragma unroll
            for (int rr = 0; rr < 2; ++rr)
#pragma unroll
                for (int q = 0; q < 4; ++q) { hv[rr][4 * q] = nx[rr][q][0]; hv[rr][4 * q + 1] = nx[rr][q][1]; hv[rr][4 * q + 2] = nx[rr][q][2]; hv[rr][4 * q + 3] = nx[rr][q][3]; }
#pragma unroll
            for (int rr = 0; rr < 2; ++rr) { const int row = rowi + r_step + rr * r_second;
#pragma unroll
                for (int q = 0; q < 4; ++q) nx[rr][q] = (row < T_) ? *((const f32x4*)((const float*)hin + (size_t)row * 1024 + 512 * (q >> 1) + 8 * lane) + (q & 1)) : (f32x4){0.f, 0.f, 0.f, 0.f}; }
        }
#pragma unroll
        for (int rr = 0; rr < NRR; ++rr) { const int row = row0 + rr * r_second; if (MODE != 0 && row < T_) {
#pragma unroll
            for (int hf = 0; hf < 2; ++hf) {
                if (MODE == 0 || HF32) { const f32x4* hp = (const f32x4*)((const float*)hin + (size_t)row * 1024 + 512 * hf + 8 * lane); const f32x4 a = hp[0], b = hp[1];
                    hv[rr][8 * hf + 0] = a[0]; hv[rr][8 * hf + 1] = a[1]; hv[rr][8 * hf + 2] = a[2]; hv[rr][8 * hf + 3] = a[3]; hv[rr][8 * hf + 4] = b[0]; hv[rr][8 * hf + 5] = b[1]; hv[rr][8 * hf + 6] = b[2]; hv[rr][8 * hf + 7] = b[3]; }
                else { const v4u hw = PIPE ? chw[rr][hf] : *(const v4u*)((const bf16*)hin + (size_t)row * 1024 + 512 * hf + 8 * lane);
                    hv[rr][8 * hf + 0] = bflo(hw.x); hv[rr][8 * hf + 1] = bfhi(hw.x); hv[rr][8 * hf + 2] = bflo(hw.y); hv[rr][8 * hf + 3] = bfhi(hw.y); hv[rr][8 * hf + 4] = bflo(hw.z); hv[rr][8 * hf + 5] = bfhi(hw.z); hv[rr][8 * hf + 6] = bflo(hw.w); hv[rr][8 * hf + 7] = bfhi(hw.w); }
                if (MODE != 0) { const v4u yw = PIPE ? cyw[rr][hf] : *(const v4u*)(y + (size_t)row * ldy + 512 * hf + 8 * lane);
                    yv[rr][8 * hf + 0] = bflo(yw.x); yv[rr][8 * hf + 1] = bfhi(yw.x); yv[rr][8 * hf + 2] = bflo(yw.y); yv[rr][8 * hf + 3] = bfhi(yw.y); yv[rr][8 * hf + 4] = bflo(yw.z); yv[rr][8 * hf + 5] = bfhi(yw.z); yv[rr][8 * hf + 6] = bflo(yw.w); yv[rr][8 * hf + 7] = bfhi(yw.w); }
            } } }
#pragma unroll
        for (int rr = 0; rr < NRR; ++rr) { const int row = row0 + rr * r_second; if (row < T_) {
            if (MODE != 0) {
                float s = 0.f;
#pragma unroll
                for (int e = 0; e < 16; ++e) s += yv[rr][e] * yv[rr][e];
                const float r = rsqrtf(wave_sum(s) * (1.f / 1024.f) + EPS_);
#pragma unroll
                for (int e = 0; e < 16; ++e) hv[rr][e] += yv[rr][e] * r * g[e];
            }
            if (MODE == 2) {
#pragma unroll
                for (int hf = 0; hf < 2; ++hf) { f32x4* op = (f32x4*)(outf + (size_t)row * 1024 + 512 * hf + 8 * lane);
                    op[0] = (f32x4){hv[rr][8 * hf], hv[rr][8 * hf + 1], hv[rr][8 * hf + 2], hv[rr][8 * hf + 3]}; op[1] = (f32x4){hv[rr][8 * hf + 4], hv[rr][8 * hf + 5], hv[rr][8 * hf + 6], hv[rr][8 * hf + 7]}; }
            } else {
                float s = 0.f;
#pragma unroll
                for (int e = 0; e < 16; ++e) s += hv[rr][e] * hv[rr][e];
                const float r = rsqrtf(wave_sum(s) * (1.f / 1024.f) + EPS_);
#pragma unroll
                for (int hf = 0; hf < 2; ++hf) { v4u w; w.x = pk2(hv[rr][8 * hf], hv[rr][8 * hf + 1]); w.y = pk2(hv[rr][8 * hf + 2], hv[rr][8 * hf + 3]); w.z = pk2(hv[rr][8 * hf + 4], hv[rr][8 * hf + 5]); w.w = pk2(hv[rr][8 * hf + 6], hv[rr][8 * hf + 7]);
                    if (GROUPED) __builtin_amdgcn_raw_buffer_store_b128(w, hrs_, (int)(((size_t)row * 1024 + 512 * hf + 8 * lane) * 2), 0, 16); else *(v4u*)(Hout + (size_t)row * 1024 + 512 * hf + 8 * lane) = w; }
                if (lane == 0) { if (GROUPED) __builtin_amdgcn_raw_buffer_store_b32(__float_as_uint(r), rrs_, row * 4, 0, 16); else RSout[row] = r; }
                if (MODE == 0) {
                    float g8[8];
#pragma unroll
                    for (int c = 0; c < 8; ++c) { float acc = 0.f;
#pragma unroll
                        for (int hf = 0; hf < 2; ++hf) { const f32x4 w0 = wreg[c][2 * hf], w1 = wreg[c][2 * hf + 1];
                            acc += hv[rr][8 * hf] * g[8 * hf] * w0[0] + hv[rr][8 * hf + 1] * g[8 * hf + 1] * w0[1] + hv[rr][8 * hf + 2] * g[8 * hf + 2] * w0[2] + hv[rr][8 * hf + 3] * g[8 * hf + 3] * w0[3]
                                 + hv[rr][8 * hf + 4] * g[8 * hf + 4] * w1[0] + hv[rr][8 * hf + 5] * g[8 * hf + 5] * w1[1] + hv[rr][8 * hf + 6] * g[8 * hf + 6] * w1[2] + hv[rr][8 * hf + 7] * g[8 * hf + 7] * w1[3]; }
                        g8[c] = wave_sum(acc) * r; }
                    float mine = 0.f;
#pragma unroll
                    for (int c = 0; c < 8; ++c) mine = (lane == c) ? g8[c] : mine;
                    if (lane < 8) gif[(size_t)row * 8 + lane] = mine + b_if[lane];
                }
            }
        } }
    }
}

__device__ __forceinline__ void mlstm_A(const Frame& F, const bf16* Z, const bf16* ZT, const float* GIF, bf16* UT, float* NU, float* MLOC, float* BLAST) {
    const int lane = F.lane, w = F.wave, c = lane & 31, hl = lane >> 5;
    LAS float* wsc = (LAS float*)(F.lds + RING_OFF + w * 1024);
    LAS unsigned char* tb_ = F.lds + RING_OFF + 8192 + w * 16896;
    for (int unit = blockIdx.x * NWAVES + w; unit < 2048; unit += F.G * NWAVES) {
        const int bh = unit >> 7, j = unit & 127, b = bh >> 2, h = bh & 3; const size_t t0 = (size_t)b * SEQ_ + 64 * j;
        const float fg = GIF[(t0 + lane) * 8 + 4 + h], ig = GIF[(t0 + lane) * 8 + h];
        bf16x8 va[4][4];
        {
            const char* vtb = (const char*)(ZT + (size_t)(h * 128) * T_ + t0); unsigned vlo = (unsigned)(lane >> 3) * (unsigned)(T_ * 2) + (unsigned)(lane & 7) * 16u; asm volatile("" : "+v"(vlo));
#pragma unroll
            for (int half = 0; half < 2; ++half) { v4u t_[8];
#pragma unroll
                for (int i = 0; i < 8; ++i) t_[i] = *(const v4u*)(vtb + (vlo + (unsigned)(64 * half + 8 * i) * (unsigned)(T_ * 2)));
#pragma unroll
                for (int i = 0; i < 8; ++i) *(LAS v4u*)(tb_ + (8 * i + (lane >> 3)) * 144 + (lane & 7) * 16) = t_[i];
                LDS_WAIT();
#pragma unroll
                for (int dvl = 0; dvl < 2; ++dvl)
#pragma unroll
                    for (int kq = 0; kq < 4; ++kq) { const LAS unsigned char* vp = tb_ + (32 * dvl + c) * 144 + (16 * kq + 4 * hl) * 2;
                        const s16x4 a_ = *(const LAS s16x4*)vp, b_ = *(const LAS s16x4*)(vp + 16); va[2 * half + dvl][kq] = (bf16x8){a_[0], a_[1], a_[2], a_[3], b_[0], b_[1], b_[2], b_[3]}; }
                LDS_WAIT(); }
        }
        const float bcum = wave_scan_add(logsig(fg), lane);
        const float blast = __shfl(bcum, 63);
        const float g = blast - bcum + ig;
        const float mloc = wave_max(g);
        wsc[lane] = __expf(g - mloc);
        LDS_WAIT();
        f32x4 wq[4][2];
#pragma unroll
        for (int kq = 0; kq < 4; ++kq) { wq[kq][0] = *(const LAS f32x4*)(wsc + 16 * kq + 4 * hl); wq[kq][1] = *(const LAS f32x4*)(wsc + 16 * kq + 8 + 4 * hl); }
#pragma unroll
        for (int dvb = 0; dvb < 4; ++dvb)
#pragma unroll
            for (int kq = 0; kq < 4; ++kq) { const bf16x8 v = va[dvb][kq];
                va[dvb][kq] = pack8(bfs(v[0]) * wq[kq][0][0], bfs(v[1]) * wq[kq][0][1], bfs(v[2]) * wq[kq][0][2], bfs(v[3]) * wq[kq][0][3], bfs(v[4]) * wq[kq][1][0], bfs(v[5]) * wq[kq][1][1], bfs(v[6]) * wq[kq][1][2], bfs(v[7]) * wq[kq][1][3]); }
        const char* zkb = (const char*)(Z + t0 * ZC_ + h * 128);
        char* utb = (char*)(UT + (size_t)unit * 16384);
        unsigned klo = (unsigned)(lane >> 2) * (ZC_ * 2) + (unsigned)(lane & 3) * 16u; asm volatile("" : "+v"(klo));
        v4u kn[4];
#pragma unroll
        for (int i = 0; i < 4; ++i) kn[i] = *(const v4u*)(zkb + (klo + (unsigned)(16 * i) * (ZC_ * 2)));
#pragma unroll 1
        for (int dkb = 0; dkb < 4; ++dkb) {
#pragma unroll
            for (int i = 0; i < 4; ++i) *(LAS v4u*)(tb_ + ((lane >> 2) + 16 * i) * 64 + (lane & 3) * 16) = kn[i];
            { unsigned lo2 = klo + 64u * (unsigned)((dkb + 1) & 3); asm volatile("" : "+v"(lo2));
#pragma unroll
              for (int i = 0; i < 4; ++i) kn[i] = *(const v4u*)(zkb + (lo2 + (unsigned)(16 * i) * (ZC_ * 2))); }
            LDS_WAIT();
            unsigned xr[2][16];
#pragma unroll
            for (int sb = 0; sb < 2; ++sb)
#pragma unroll
                for (int r = 0; r < 16; ++r) xr[sb][r] = *(const LAS bf16*)(tb_ + (32 * sb + (r & 3) + 8 * (r >> 2) + 4 * hl) * 64 + 2 * c);
            float sn = 0.f; bf16x8 kb[4];
#pragma unroll
            for (int sb = 0; sb < 2; ++sb)
#pragma unroll
                for (int sp = 0; sp < 2; ++sp) { const int kq = 2 * sb + sp; v4u pw;
                    pw.x = xr[sb][8 * sp + 0] | (xr[sb][8 * sp + 1] << 16); pw.y = xr[sb][8 * sp + 2] | (xr[sb][8 * sp + 3] << 16); pw.z = xr[sb][8 * sp + 4] | (xr[sb][8 * sp + 5] << 16); pw.w = xr[sb][8 * sp + 6] | (xr[sb][8 * sp + 7] << 16);
                    kb[kq] = __builtin_bit_cast(bf16x8, pw);
#pragma unroll
                    for (int e = 0; e < 4; ++e) sn += __uint_as_float(xr[sb][8 * sp + e] << 16) * wq[kq][0][e] + __uint_as_float(xr[sb][8 * sp + 4 + e] << 16) * wq[kq][1][e]; }
            sn += __shfl_xor(sn, 32);
            if (hl == 0) NU[(size_t)unit * 128 + 32 * dkb + c] = sn;
            f32x16 acc[4] = {{}, {}, {}, {}};
#pragma unroll
            for (int kq = 0; kq < 4; ++kq)
#pragma unroll
                for (int dvb = 0; dvb < 4; ++dvb) acc[dvb] = MFMA32(kb[kq], va[dvb][kq], acc[dvb]);
#pragma unroll
            for (int dvb = 0; dvb < 4; ++dvb)
#pragma unroll
                for (int g4 = 0; g4 < 4; ++g4) { v2u pw; pw.x = pk2(acc[dvb][4 * g4], acc[dvb][4 * g4 + 1]); pw.y = pk2(acc[dvb][4 * g4 + 2], acc[dvb][4 * g4 + 3]);
                    *(LAS v2u*)(tb_ + 4096 + (32 * dvb + c) * 80 + (8 * g4 + 4 * hl) * 2) = pw; }
            LDS_WAIT();
            { unsigned so = (unsigned)(lane >> 2) * 256u + (unsigned)(lane & 3) * 16u + 64u * (unsigned)dkb; asm volatile("" : "+v"(so));
#pragma unroll
              for (int i = 0; i < 8; ++i) { const v4u v = *(const LAS v4u*)(tb_ + 4096 + ((lane >> 2) + 16 * i) * 80 + (lane & 3) * 16); *(v4u*)(utb + (so + (unsigned)(16 * i) * 256u)) = v; } }
            LDS_WAIT();
        }
        if (lane == 0) { MLOC[unit] = mloc; BLAST[unit] = blast; }
        LDS_WAIT();
    }
}
__device__ __forceinline__ void mlstm_B(const Frame& F, const bf16* UT, const float* NU, const float* MLOC, const float* BLAST, bf16* CT, float* NPREV, float* MPREV) {
    const unsigned* U32 = (const unsigned*)UT; unsigned* C32 = (unsigned*)CT;
    constexpr int NB = 32;
    for (int g = blockIdx.x * (NWAVES * 64) + F.tid; g < 16 * 8192; g += F.G * NWAVES * 64) {
        const int bh = __builtin_amdgcn_readfirstlane(g >> 13), e2 = g & 8191;
        float m = 0.f, c0 = 0.f, c1 = 0.f, n0 = 0.f, n1 = 0.f;
        unsigned un[NB];
        int mlvn = __float_as_int(MLOC[bh * 128 + (F.lane & (NB - 1))]), blvn = __float_as_int(BLAST[bh * 128 + (F.lane & (NB - 1))]);
#pragma unroll
        for (int jj = 0; jj < NB; ++jj) un[jj] = __builtin_nontemporal_load(U32 + (size_t)(bh * 128 + jj) * 8192 + e2);
#pragma unroll 1
        for (int j0 = 0; j0 < 128; j0 += NB) {
            unsigned u[NB];
#pragma unroll
            for (int jj = 0; jj < NB; ++jj) u[jj] = un[jj];
            const int mlv = mlvn, blv = blvn;
            if (j0 + NB < 128) {
                mlvn = __float_as_int(MLOC[bh * 128 + j0 + NB + (F.lane & (NB - 1))]); blvn = __float_as_int(BLAST[bh * 128 + j0 + NB + (F.lane & (NB - 1))]);
#pragma unroll
                for (int jj = 0; jj < NB; ++jj) un[jj] = __builtin_nontemporal_load(U32 + (size_t)(bh * 128 + j0 + NB + jj) * 8192 + e2);
            }
#pragma unroll
            for (int jj = 0; jj < NB; ++jj) {
                const int unit = bh * 128 + j0 + jj; const size_t idx = (size_t)unit * 8192 + e2;
                C32[idx] = pk2(c0, c1);
                if (e2 == 0) MPREV[unit] = m;
                const float ml = __int_as_float(__builtin_amdgcn_readlane(mlv, jj)), bl = __int_as_float(__builtin_amdgcn_readlane(blv, jj));
                const float mn = fmaxf(bl + m, ml); const float wp = __expf(bl + m - mn), wsn = __expf(ml - mn);
                c0 = wp * c0 + wsn * bflo(u[jj]); c1 = wp * c1 + wsn * bfhi(u[jj]);
                m = mn;
            }
        }
    }
    for (int g2 = blockIdx.x * (NWAVES * 64) + F.tid; g2 < 16 * 64; g2 += F.G * NWAVES * 64) {
        const int bh = __builtin_amdgcn_readfirstlane(g2 >> 6), e2 = g2 & 63;
        float m = 0.f, n0 = 0.f, n1 = 0.f;
        f32x2_t nun[NB];
        int mlvn = __float_as_int(MLOC[bh * 128 + (F.lane & (NB - 1))]), blvn = __float_as_int(BLAST[bh * 128 + (F.lane & (NB - 1))]);
#pragma unroll
        for (int jj = 0; jj < NB; ++jj) nun[jj] = *(const f32x2_t*)(NU + (size_t)(bh * 128 + jj) * 128 + 2 * e2);
#pragma unroll 1
        for (int j0 = 0; j0 < 128; j0 += NB) {
            f32x2_t nu[NB];
#pragma unroll
            for (int jj = 0; jj < NB; ++jj) nu[jj] = nun[jj];
            const int mlv = mlvn, blv = blvn;
            if (j0 + NB < 128) {
                mlvn = __float_as_int(MLOC[bh * 128 + j0 + NB + (F.lane & (NB - 1))]); blvn = __float_as_int(BLAST[bh * 128 + j0 + NB + (F.lane & (NB - 1))]);
#pragma unroll
                for (int jj = 0; jj < NB; ++jj) nun[jj] = *(const f32x2_t*)(NU + (size_t)(bh * 128 + j0 + NB + jj) * 128 + 2 * e2);
            }
#pragma unroll
            for (int jj = 0; jj < NB; ++jj) {
                const int unit = bh * 128 + j0 + jj;
                *(f32x2_t*)(NPREV + (size_t)unit * 128 + 2 * e2) = (f32x2_t){n0, n1};
                const float ml = __int_as_float(__builtin_amdgcn_readlane(mlv, jj)), bl = __int_as_float(__builtin_amdgcn_readlane(blv, jj));
                const float mn = fmaxf(bl + m, ml); const float wp = __expf(bl + m - mn), wsn = __expf(ml - mn);
                n0 = wp * n0 + wsn * nu[jj][0]; n1 = wp * n1 + wsn * nu[jj][1];
                m = mn;
            }
        }
    }
}
constexpr int MC_TS = 256, MC_TS2 = 144, MC_BUF = 16896;
static_assert(64 * MC_TS <= MC_BUF && 64 * MC_TS2 <= MC_BUF && 8192 + 8 * MC_BUF <= LDSCTL_OFF, "mlstm_C LDS map");
__device__ __forceinline__ void mlstm_C(const Frame& F, const bf16* Z, const bf16* ZT, const float* GIF, const bf16* CT, const float* NPREV, const float* MPREV, bf16* YC) {
    const int lane = F.lane, w = F.wave, c = lane & 31, hl = lane >> 5;
    LAS float* wsc = (LAS float*)(F.lds + RING_OFF + w * 1024);
    LAS unsigned char* tb_ = F.lds + RING_OFF + 8192 + w * MC_BUF;
    unsigned swo[8];
#pragma unroll
    for (int ks = 0; ks < 8; ++ks) swo[ks] = (unsigned)c * 256u + ((unsigned)((2 * ks) ^ (hl ^ (c & 15))) << 4);
#define MC_STAGE256(srcv, pitchv, coffv) do { const char* s_ = (const char*)(srcv); unsigned lo_ = (unsigned)(lane >> 4) * (unsigned)(pitchv) + (unsigned)(lane & 15) * 16u + (unsigned)(coffv); \
        asm volatile("" : "+v"(lo_));     \
        _Pragma("unroll") for (int hb_ = 0; hb_ < 4; ++hb_) { v4u t_[4]; \
            _Pragma("unroll") for (int i_ = 0; i_ < 4; ++i_) t_[i_] = *(const v4u*)(s_ + (lo_ + (unsigned)(4 * (4 * hb_ + i_)) * (unsigned)(pitchv))); \
            _Pragma("unroll") for (int i_ = 0; i_ < 4; ++i_) { const int r_ = 4 * (4 * hb_ + i_) + (lane >> 4); *(LAS v4u*)(tb_ + r_ * MC_TS + (((lane & 15) ^ (r_ & 15)) << 4)) = t_[i_]; } \
            asm volatile("" ::: "memory"); } } while (0)
#define MC_STAGE128(srcv, pitchv, coffv) do { const char* s_ = (const char*)(srcv); unsigned lo_ = (unsigned)(lane >> 3) * (unsigned)(pitchv) + (unsigned)(lane & 7) * 16u + (unsigned)(coffv); \
        asm volatile("" : "+v"(lo_)); \
        _Pragma("unroll") for (int hb_ = 0; hb_ < 2; ++hb_) { v4u t_[4]; \
            _Pragma("unroll") for (int i_ = 0; i_ < 4; ++i_) t_[i_] = *(const v4u*)(s_ + (lo_ + (unsigned)(8 * (4 * hb_ + i_)) * (unsigned)(pitchv))); \
            _Pragma("unroll") for (int i_ = 0; i_ < 4; ++i_) { const int r_ = 8 * (4 * hb_ + i_) + (lane >> 3); *(LAS v4u*)(tb_ + r_ * MC_TS2 + (lane & 7) * 16) = t_[i_]; } \
            asm volatile("" ::: "memory"); } } while (0)
    for (int unit = blockIdx.x * NWAVES + w; unit < 2048; unit += F.G * NWAVES) {
        const int bh = unit >> 7, j = unit & 127, b = bh >> 2, h = bh & 3; const size_t t0 = (size_t)b * SEQ_ + 64 * j;
        { const float fg = GIF[(t0 + lane) * 8 + 4 + h], ig = GIF[(t0 + lane) * 8 + h];
          const float mprev = MPREV[unit];
          const float bcum = wave_scan_add(logsig(fg), lane);
          const float cs = ig - bcum; const float cmax = wave_scan_max(cs, lane);
          const float Mt = fmaxf(mprev, cmax);
          wsc[lane] = cs; wsc[64 + lane] = Mt; wsc[128 + lane] = __expf(mprev - Mt); wsc[192 + lane] = __expf(-(bcum + Mt)); }
        const bf16* uQ = Z + t0 * ZC_ + h * 128;
        const bf16* uV = ZT + (size_t)(h * 128) * T_ + t0;
        const bf16* uC = CT + (size_t)unit * 16384;
        const float* uN = NPREV + (size_t)unit * 128;
        bf16* uY = YC + t0 * D_ + h * 128;
        MC_STAGE256(uQ, ZC_ * 2, 1024);
        LDS_WAIT();
        bf16x8 qf[2][8];
#pragma unroll
        for (int tb = 0; tb < 2; ++tb)
#pragma unroll
            for (int ks = 0; ks < 8; ++ks) qf[tb][ks] = *(const LAS bf16x8*)(tb_ + swo[ks] + tb * 8192);
        LDS_WAIT();
        MC_STAGE256(uQ, ZC_ * 2, 0);
        LDS_WAIT();
        bf16x8 pf[2][2][2];
#pragma unroll
        for (int tb = 0; tb < 2; ++tb) {
            const int t = 32 * tb + c;
            const float Mt_c = wsc[64 + t], dec_c = wsc[128 + t], em_c = wsc[192 + t];
            float dsum = 0.f;
#pragma unroll
            for (int sb = 0; sb < 2; ++sb) {
                pf[tb][sb][0] = (bf16x8){}; pf[tb][sb][1] = (bf16x8){};
                if (sb <= tb) {
                    f32x16 sacc = {};
#pragma unroll
                    for (int ks = 0; ks < 8; ++ks) sacc = MFMA32(*(const LAS bf16x8*)(tb_ + swo[ks] + sb * 8192), qf[tb][ks], sacc);
                    float pv[16];
#pragma unroll
                    for (int g4 = 0; g4 < 4; ++g4) { const int s0 = 32 * sb + 8 * g4 + 4 * hl; const f32x4 cs4 = *(const LAS f32x4*)(wsc + s0);
#pragma unroll
                        for (int e = 0; e < 4; ++e) { const float v = (s0 + e <= t) ? sacc[4 * g4 + e] * __expf(cs4[e] - Mt_c) : 0.f; pv[4 * g4 + e] = v; dsum += v; } }
#pragma unroll
                    for (int ss = 0; ss < 2; ++ss) pf[tb][sb][ss] = pack8(pv[8 * ss], pv[8 * ss + 1], pv[8 * ss + 2], pv[8 * ss + 3], pv[8 * ss + 4], pv[8 * ss + 5], pv[8 * ss + 6], pv[8 * ss + 7]);
                }
            }
            dsum += __shfl_xor(dsum, 32);
            float qn = 0.f;
            { const unsigned no = 32 * hl;
#pragma unroll
              for (int ks = 0; ks < 8; ++ks) { const f32x4 n0 = *(const f32x4*)((const char*)uN + no + 64 * ks), n1 = *(const f32x4*)((const char*)uN + no + 64 * ks + 16);
                  qn += bfs(qf[tb][ks][0]) * n0[0] + bfs(qf[tb][ks][1]) * n0[1] + bfs(qf[tb][ks][2]) * n0[2] + bfs(qf[tb][ks][3]) * n0[3] + bfs(qf[tb][ks][4]) * n1[0] + bfs(qf[tb][ks][5]) * n1[1] + bfs(qf[tb][ks][6]) * n1[2] + bfs(qf[tb][ks][7]) * n1[3];
                  if ((ks & 3) == 3) asm volatile("" ::: "memory"); } }
            qn += __shfl_xor(qn, 32);
            const float den = dsum + dec_c * qn; const float inv_t = 1.0f / fmaxf(fabsf(den), em_c);
            if (hl == 0) wsc[192 + t] = inv_t;
        }
        LDS_WAIT();
#pragma unroll 1
        for (int dq = 0; dq < 4; ++dq) {
            { const char* s_ = (const char*)(uC + (size_t)dq * 32 * 128); unsigned lo_ = (unsigned)(lane >> 4) * 256u + (unsigned)(lane & 15) * 16u; asm volatile("" : "+v"(lo_));
#pragma unroll
              for (int hb_ = 0; hb_ < 2; ++hb_) { v4u t_[4];
#pragma unroll
                  for (int i_ = 0; i_ < 4; ++i_) t_[i_] = *(const v4u*)(s_ + (lo_ + (unsigned)(4 * (4 * hb_ + i_)) * 256u));
#pragma unroll
                  for (int i_ = 0; i_ < 4; ++i_) { const int r_ = 4 * (4 * hb_ + i_) + (lane >> 4); *(LAS v4u*)(tb_ + r_ * MC_TS + (((lane & 15) ^ (r_ & 15)) << 4)) = t_[i_]; }
                  asm volatile("" ::: "memory"); } }
            LDS_WAIT();
            f32x16 acc[2] = {{}, {}};
#pragma unroll
            for (int ks = 0; ks < 8; ++ks) { const bf16x8 cf = *(const LAS bf16x8*)(tb_ + swo[ks]); acc[0] = MFMA32(cf, qf[0][ks], acc[0]); acc[1] = MFMA32(cf, qf[1][ks], acc[1]); }
#pragma unroll
            for (int tb = 0; tb < 2; ++tb) acc[tb] = acc[tb] * wsc[128 + 32 * tb + c];
            LDS_WAIT();
            { const char* s_ = (const char*)(uV + (size_t)dq * 32 * T_); unsigned lo_ = (unsigned)(lane >> 3) * (unsigned)(T_ * 2) + (unsigned)(lane & 7) * 16u; asm volatile("" : "+v"(lo_));
              v4u t_[4];
#pragma unroll
              for (int i_ = 0; i_ < 4; ++i_) t_[i_] = *(const v4u*)(s_ + (lo_ + (unsigned)(8 * i_) * (unsigned)(T_ * 2)));
#pragma unroll
              for (int i_ = 0; i_ < 4; ++i_) { const int r_ = 8 * i_ + (lane >> 3); *(LAS v4u*)(tb_ + r_ * MC_TS2 + (lane & 7) * 16) = t_[i_]; }
              asm volatile("" ::: "memory"); }
            LDS_WAIT();
#pragma unroll
            for (int sb = 0; sb < 2; ++sb)
#pragma unroll
                for (int ss = 0; ss < 2; ++ss) { const LAS unsigned char* vp = tb_ + c * MC_TS2 + 64 * sb + 32 * ss + 8 * hl;
                    const s16x4 va = *(const LAS s16x4*)vp, vb = *(const LAS s16x4*)(vp + 16); const bf16x8 vf = (bf16x8){va[0], va[1], va[2], va[3], vb[0], vb[1], vb[2], vb[3]};
                    if (sb == 0) acc[0] = MFMA32(vf, pf[0][0][ss], acc[0]);
                    acc[1] = MFMA32(vf, pf[1][sb][ss], acc[1]); }
            LDS_WAIT();
            { const char* s_ = (const char*)uQ; unsigned lo_ = (unsigned)(lane >> 2) * (unsigned)(ZC_ * 2) + (unsigned)(lane & 3) * 16u + 2048u + 64u * dq; asm volatile("" : "+v"(lo_));
              v4u t_[4];
#pragma unroll
              for (int i_ = 0; i_ < 4; ++i_) t_[i_] = *(const v4u*)(s_ + (lo_ + (unsigned)(16 * i_) * (unsigned)(ZC_ * 2)));
#pragma unroll
              for (int i_ = 0; i_ < 4; ++i_) { const int r_ = 16 * i_ + (lane >> 2); *(LAS v4u*)(tb_ + r_ * 80 + (lane & 3) * 16) = t_[i_]; }
              asm volatile("" ::: "memory"); }
            LDS_WAIT();
#pragma unroll
            for (int tb = 0; tb < 2; ++tb) { const float inv_t = wsc[192 + 32 * tb + c];
#pragma unroll
                for (int g4 = 0; g4 < 4; ++g4) { LAS unsigned char* op = tb_ + (32 * tb + c) * 80 + 16 * g4 + 8 * hl;
                    const v2u og = *(const LAS v2u*)op; float y[4]; const float o4[4] = {bflo(og.x), bfhi(og.x), bflo(og.y), bfhi(og.y)};
#pragma unroll
                    for (int e = 0; e < 4; ++e) y[e] = fsigmoid(o4[e]) * (acc[tb][4 * g4 + e] * inv_t);
                    v2u o; o.x = pk2(y[0], y[1]); o.y = pk2(y[2], y[3]); *(LAS v2u*)op = o; } }
            LDS_WAIT();
            { unsigned yo_ = (unsigned)(lane >> 2) * (D_ * 2) + (unsigned)(lane & 3) * 16u + 64u * dq; asm volatile("" : "+v"(yo_));
#pragma unroll
              for (int i_ = 0; i_ < 4; ++i_) { const int r_ = 16 * i_ + (lane >> 2); const v4u v = *(const LAS v4u*)(tb_ + r_ * 80 + (lane & 3) * 16);
                  *(v4u*)((char*)uY + (yo_ + (unsigned)(16 * i_) * (D_ * 2))) = v; } }
            LDS_WAIT();
        }
    }
#undef MC_STAGE256
#undef MC_STAGE128
}

__device__ __forceinline__ void rg_A(const Frame& F, const bf16* Z, const float* conv_w, const float* conv_b, const bf16* RGW, const float* rg_ba, const float* rg_bx, const float* SP,
                                     float* ACH, float* HCH, unsigned* AU) {
    constexpr int XS = 136;
    const int lane = F.lane, w = F.wave, c = lane & 31, hl = lane >> 5;
    LAS bf16* XC = (LAS bf16*)(F.lds + RING_OFF + w * 17408);
    for (int task = blockIdx.x * NWAVES + w; task < 2048; task += F.G * NWAVES) {
        const int n = task & 3, cj = (task >> 2) & 127, b = task >> 9; const size_t row0 = (size_t)b * SEQ_ + 64 * cj;
        {
            const int cg = lane & 15, tq = lane >> 4, ch = 128 * n + 8 * cg;
            float cw[4][8], cb[8];
#pragma unroll
            for (int e = 0; e < 8; ++e) { cb[e] = conv_b[ch + e]; cw[0][e] = conv_w[ch + e]; cw[1][e] = conv_w[512 + ch + e]; cw[2][e] = conv_w[1024 + ch + e]; cw[3][e] = conv_w[1536 + ch + e]; }
            bf16x8 rin[19];
#pragma unroll
            for (int i = 0; i < 19; ++i) { const int tt = 16 * tq - 3 + i; rin[i] = (bf16x8){}; if (64 * cj + tt >= 0) rin[i] = ldg8(Z + (size_t)((long)row0 + tt) * ZC_ + 1536 + ch); }
#pragma unroll
            for (int i = 0; i < 16; ++i) { float o[8];
#pragma unroll
                for (int e = 0; e < 8; ++e) o[e] = cb[e] + cw[0][e] * bfs(rin[i][e]) + cw[1][e] * bfs(rin[i + 1][e]) + cw[2][e] * bfs(rin[i + 2][e]) + cw[3][e] * bfs(rin[i + 3][e]);
                v4u pw; pw.x = pk2(o[0], o[1]); pw.y = pk2(o[2], o[3]); pw.z = pk2(o[4], o[5]); pw.w = pk2(o[6], o[7]);
                *(LAS v4u*)(XC + (16 * tq + i) * XS + 8 * cg) = pw; }
        }
        LDS_WAIT();
#pragma unroll 1
        for (int dblk = 0; dblk < 4; ++dblk) {
            const int chl = 32 * dblk + c, chg = 128 * n + chl;
            f32x16 accA[2] = {{}, {}}, accX[2] = {{}, {}};
            { const bf16* wa = RGW + ((size_t)n * 128 + chl) * 128 + 8 * hl; const bf16* wx = wa + 65536;
              const LAS bf16* xa = XC + c * XS + 8 * hl;
#pragma unroll
              for (int kh = 0; kh < 2; ++kh) { bf16x8 fa[4], fx[4];
#pragma unroll
                  for (int k4 = 0; k4 < 4; ++k4) { fa[k4] = ldg8(wa + 16 * (4 * kh + k4)); fx[k4] = ldg8(wx + 16 * (4 * kh + k4)); }
                  asm volatile("" : "+v"(fa[0]), "+v"(fa[1]), "+v"(fa[2]), "+v"(fa[3]), "+v"(fx[0]), "+v"(fx[1]), "+v"(fx[2]), "+v"(fx[3]));
#pragma unroll
                  for (int k4 = 0; k4 < 4; ++k4) { const int ks = 4 * kh + k4;
#pragma unroll
                      for (int tb = 0; tb < 2; ++tb) { const bf16x8 af = *(const LAS bf16x8*)(xa + 32 * tb * XS + 16 * ks); accA[tb] = MFMA32(af, fa[k4], accA[tb]); accX[tb] = MFMA32(af, fx[k4], accX[tb]); } } } }
            const float ba_c = rg_ba[chg], bx_c = rg_bx[chg], sp_c = SP[chg];
            const __amdgpu_buffer_rsrc_t aur_ = __builtin_amdgcn_make_buffer_rsrc((void*)AU, 0, 0x7fffffff, 0x00020000); const int auo_ = (int)(((row0 + 4 * hl) * 512 + chg) * 4);
            float Ps[8], Hs[8];
#pragma unroll
            for (int tb = 0; tb < 2; ++tb)
#pragma unroll
                for (int g4 = 0; g4 < 4; ++g4) { float P = 1.f, H = 0.f;
#pragma unroll
                    for (int e = 0; e < 4; ++e) { const int r = 4 * g4 + e, t = 32 * tb + 8 * g4 + 4 * hl + e;
                        const float ra = fsigmoid(accA[tb][r] + ba_c), ri = fsigmoid(accX[tb][r] + bx_c); const float la = -ra * sp_c; const float av = __expf(la);
                        const float x2 = 2.f * la; const float om = (x2 > -0.02f) ? -x2 * (1.f + x2 * (0.5f + x2 * (1.f / 6.f))) : (1.f - av * av);
                        const float xcv = __uint_as_float(((unsigned)XC[t * XS + chl]) << 16);
                        const float uv = __builtin_amdgcn_sqrtf(om) * ri * xcv;
                        P *= av; H = av * H + uv;
                        __builtin_amdgcn_raw_buffer_store_b32(pk2(1.f - av, uv), aur_, auo_, (32 * tb + 8 * g4 + e) * 2048, 0); }
                    Ps[4 * tb + g4] = P; Hs[4 * tb + g4] = H; }
            float Po[8], Ho[8];
#pragma unroll
            for (int i = 0; i < 8; ++i) { Po[i] = __shfl_xor(Ps[i], 32); Ho[i] = __shfl_xor(Hs[i], 32); }
            float carry = 0.f, AP = 1.f;
#pragma unroll
            for (int i = 0; i < 8; ++i) {
                const float P0 = hl == 0 ? Ps[i] : Po[i], H0 = hl == 0 ? Hs[i] : Ho[i], P1 = hl == 0 ? Po[i] : Ps[i], H1 = hl == 0 ? Ho[i] : Hs[i];
                carry = P0 * carry + H0; carry = P1 * carry + H1; AP *= P0 * P1; }
            if (hl == 0) { ACH[((size_t)b * 128 + cj) * 512 + chg] = AP; HCH[((size_t)b * 128 + cj) * 512 + chg] = carry; }
        }
        LDS_WAIT();
    }
}
__device__ __forceinline__ void rg_B(const Frame& F, const float* ACH, const float* HCH, float* HIN) {
    const int g = (F.G - 1 - (int)blockIdx.x) * (NWAVES * 64) + F.tid;
    if (g < 16384) {
        const int sc = g >> 3, p = g & 7, b = sc >> 9, ch = sc & 511;
        float a[16], h[16];
#pragma unroll
        for (int i = 0; i < 16; ++i) { const size_t idx = ((size_t)b * 128 + 16 * p + i) * 512 + ch; a[i] = ACH[idx]; h[i] = HCH[idx]; }
        float Ap = 1.f, Hp = 0.f;
#pragma unroll
        for (int i = 0; i < 16; ++i) { Hp = a[i] * Hp + h[i]; Ap *= a[i]; }
        float As = Ap, Hs = Hp;
#pragma unroll
        for (int o = 1; o < 8; o <<= 1) { const float Ao = __shfl_up(As, o, 8), Ho = __shfl_up(Hs, o, 8); if (p >= o) { Hs = As * Ho + Hs; As = As * Ao; } }
        float Hin = __shfl_up(Hs, 1, 8); if (p == 0) Hin = 0.f;
#pragma unroll
        for (int i = 0; i < 16; ++i) { const size_t idx = ((size_t)b * 128 + 16 * p + i) * 512 + ch; HIN[idx] = Hin; Hin = a[i] * Hin + h[i]; }
    }
}
__device__ __forceinline__ void rg_C(const Frame& F, const bf16* Z, const unsigned* AU, const float* HIN, bf16* YC) {
    const int lane = F.lane;
    for (int task = blockIdx.x * NWAVES + F.wave; task < 2048; task += F.G * NWAVES) {
        const int cg = task & 3, cj = (task >> 2) & 127, b = task >> 9; const size_t row0 = (size_t)b * SEQ_ + 64 * cj; const int ch = 128 * cg + 2 * lane;
        const float* hp = HIN + ((size_t)b * 128 + cj) * 512 + ch; float h0 = hp[0], h1 = hp[1];
        v2u aun[16]; unsigned ryn[16];
#pragma unroll
        for (int i = 0; i < 16; ++i) { aun[i] = *(const v2u*)(AU + (row0 + i) * 512 + ch); ryn[i] = *(const unsigned*)(Z + (row0 + i) * ZC_ + 2048 + ch); }
#pragma unroll 1
        for (int t0 = 0; t0 < 64; t0 += 16) {
            v2u au[16]; unsigned ry[16];
#pragma unroll
            for (int i = 0; i < 16; ++i) { au[i] = aun[i]; ry[i] = ryn[i]; }
            if (t0 + 16 < 64) {
#pragma unroll
                for (int i = 0; i < 16; ++i) { aun[i] = *(const v2u*)(AU + (row0 + t0 + 16 + i) * 512 + ch); ryn[i] = *(const unsigned*)(Z + (row0 + t0 + 16 + i) * ZC_ + 2048 + ch); }
            }
#pragma unroll
            for (int i = 0; i < 16; ++i) { h0 = (1.f - bflo(au[i].x)) * h0 + bfhi(au[i].x); h1 = (1.f - bflo(au[i].y)) * h1 + bfhi(au[i].y);
                const float r0 = bflo(ry[i]), r1 = bfhi(ry[i]);
                const float g0 = r0 * fsigmoid(1.5957691216057308f * (r0 + 0.044715f * r0 * r0 * r0)), g1 = r1 * fsigmoid(1.5957691216057308f * (r1 + 0.044715f * r1 * r1 * r1));
                *(unsigned*)(YC + (row0 + t0 + i) * D_ + 512 + ch) = pk2(g0 * h0, g1 * h1); }
        }
    }
}

constexpr int SK_STRIDE = 144, SV_STRIDE = 528, SBUF_V = 36864, SBUF = 36864 + 33792;
static_assert(2 * SBUF <= LDSCTL_OFF && MISC_OFF + 128 <= LDS_BYTES, "LDS map");
__device__ __forceinline__ void swa_phase(const Frame& F, const bf16* QK, const bf16* VT, const float* sinks, bf16* O) {
    const int lane = F.lane, w = F.wave, c = lane & 31, hl = lane >> 5, tid = F.tid;
    LAS unsigned char* lb = F.lds + RING_OFF;
    const int nun = (1024 - (int)blockIdx.x + F.G - 1) / F.G;
    v4u sk[4], sv[4];
#define SW_LOAD(uiv) do { const int un_ = (int)blockIdx.x + (uiv) * F.G, b_ = un_ >> 8, kvh_ = (un_ >> 6) & 3, j_ = un_ & 63; const long k0_ = (long)b_ * SEQ_ + 128 * (j_ - 1); \
        _Pragma("unroll") for (int q_ = 0; q_ < 4; ++q_) { const int p_ = tid + 512 * q_; const int kr_ = p_ >> 3; const int vk_ = (p_ & 31) * 8; \
            sk[q_] = (j_ > 0 || kr_ >= 128) ? *(const v4u*)(QK + (size_t)(k0_ + kr_) * QKC_ + 1024 + kvh_ * 64 + (p_ & 7) * 8) : (v4u){0u, 0u, 0u, 0u}; \
            sv[q_] = (j_ > 0 || kr_ >= 128) ? *(const v4u*)(QK + (size_t)(k0_ + kr_) * QKC_ + 1280 + kvh_ * 64 + (p_ & 7) * 8) : (v4u){0u, 0u, 0u, 0u}; (void)vk_; } } while (0)
#define SW_STORE(uiv) do { LAS unsigned char* bf_ = lb + ((uiv) & 1) * SBUF; \
        _Pragma("unroll") for (int q_ = 0; q_ < 4; ++q_) { const int p_ = tid + 512 * q_; *(LAS v4u*)(bf_ + (p_ >> 3) * SK_STRIDE + (p_ & 7) * 16) = sk[q_]; { const int kr2_ = p_ >> 3; const int kp_ = (kr2_ & ~15) + 8 * ((kr2_ >> 2) & 1) + 4 * ((kr2_ >> 3) & 1) + (kr2_ & 3);     \
              LAS bf16* vd_ = (LAS bf16*)(bf_ + SBUF_V + ((p_ & 7) * 8) * SV_STRIDE + kp_ * 2);     \
              vd_[0] = (bf16)(sv[q_].x & 0xffffu); vd_[SV_STRIDE / 2] = (bf16)(sv[q_].x >> 16); vd_[2 * (SV_STRIDE / 2)] = (bf16)(sv[q_].y & 0xffffu); vd_[3 * (SV_STRIDE / 2)] = (bf16)(sv[q_].y >> 16); \
              vd_[4 * (SV_STRIDE / 2)] = (bf16)(sv[q_].z & 0xffffu); vd_[5 * (SV_STRIDE / 2)] = (bf16)(sv[q_].z >> 16); vd_[6 * (SV_STRIDE / 2)] = (bf16)(sv[q_].w & 0xffffu); vd_[7 * (SV_STRIDE / 2)] = (bf16)(sv[q_].w >> 16); } } } while (0)
    if (nun <= 0) return;
    SW_LOAD(0); SW_STORE(0); __syncthreads();
    bf16x8 qn[4];
    { const int un0 = (int)blockIdx.x, b0 = un0 >> 8, kvh0 = (un0 >> 6) & 3, j0 = un0 & 63; const size_t row0_ = (size_t)b0 * SEQ_ + 128 * j0 + 64 * (w & 1) + c;
#pragma unroll
      for (int ks = 0; ks < 4; ++ks) qn[ks] = ldg8(QK + row0_ * QKC_ + (kvh0 * 4 + (w >> 1)) * 64 + 16 * ks + 8 * hl); }
    for (int ui = 0; ui < nun; ++ui) {
        const int unit = (int)blockIdx.x + ui * F.G;
        const int b = unit >> 8, kvh = (unit >> 6) & 3, j = unit & 63; const int head = kvh * 4 + (w >> 1); const float sink2 = sinks[head] * 1.4426950408889634f;
        if (ui + 1 < nun) SW_LOAD(ui + 1);
        const LAS unsigned char* kbuf = lb + (ui & 1) * SBUF + c * SK_STRIDE + 16 * hl; const LAS unsigned char* vbuf = lb + (ui & 1) * SBUF + SBUF_V + c * SV_STRIDE + 16 * hl;
#pragma unroll 1
        for (int qb2 = 0; qb2 < 2; ++qb2) {
            const int qo = 64 * (w & 1) + 32 * qb2, q0 = 128 * j + qo; const size_t row = (size_t)b * SEQ_ + q0 + c;
            bf16x8 qf[4];
#pragma unroll
            for (int ks = 0; ks < 4; ++ks) qf[ks] = qn[ks];
            {
                const int un2 = (qb2 == 0) ? unit : ((ui + 1 < nun) ? unit + F.G : unit); const int b2 = un2 >> 8, kvh2 = (un2 >> 6) & 3, j2 = un2 & 63;
                const size_t row2 = (size_t)b2 * SEQ_ + 128 * j2 + 64 * (w & 1) + ((qb2 == 0) ? 32 : 0) + c;
#pragma unroll
                for (int ks = 0; ks < 4; ++ks) qn[ks] = ldg8(QK + row2 * QKC_ + (kvh2 * 4 + (w >> 1)) * 64 + 16 * ks + 8 * hl); }
            const int lb0 = qo >> 5;
            const int i0 = (j == 0 && lb0 < 4) ? 4 - lb0 : 0;
            f32x16 o[2] = {{}, {}}; float sum = 0.f;
#pragma unroll
            for (int i = 0; i < 5; ++i) {
                if (i >= i0) {
                    f32x16 sc = {};
#pragma unroll
                    for (int ks = 0; ks < 4; ++ks) sc = MFMA32(*(const LAS bf16x8*)(kbuf + (lb0 + i) * 32 * SK_STRIDE + 32 * ks), qf[ks], sc);
                    float pe[16];
#pragma unroll
                    for (int r = 0; r < 16; ++r) { const int kk = (r & 3) + 8 * (r >> 2) + 4 * hl; float pp = __builtin_amdgcn_exp2f(__builtin_amdgcn_fmed3f(sc[r], -3.0e38f, 80.f));
                        if (i == 0) pp = kk > c ? pp : 0.f;
                        if (i == 4) pp = kk <= c ? pp : 0.f;
                        pe[r] = pp; sum += pp; }
#pragma unroll
                    for (int ss = 0; ss < 2; ++ss) { const bf16x8 pf = pack8(pe[8 * ss], pe[8 * ss + 1], pe[8 * ss + 2], pe[8 * ss + 3], pe[8 * ss + 4], pe[8 * ss + 5], pe[8 * ss + 6], pe[8 * ss + 7]);
#pragma unroll
                        for (int db = 0; db < 2; ++db) o[db] = MFMA32(*(const LAS bf16x8*)(vbuf + db * 32 * SV_STRIDE + 64 * (lb0 + i) + 32 * ss), pf, o[db]); }
                }
            }
            sum += __shfl_xor(sum, 32); const float inv = 1.0f / (sum + __builtin_amdgcn_exp2f(sink2));
            bf16* orow = O + row * D_ + head * 64 + 4 * hl;
#pragma unroll
            for (int db = 0; db < 2; ++db)
#pragma unroll
                for (int g4 = 0; g4 < 4; ++g4) { v2u ov; ov.x = pk2(o[db][4 * g4] * inv, o[db][4 * g4 + 1] * inv); ov.y = pk2(o[db][4 * g4 + 2] * inv, o[db][4 * g4 + 3] * inv); *(v2u*)(orow + 32 * db + 8 * g4) = ov; }
        }
        if (ui + 1 < nun) SW_STORE(ui + 1);
        LDS_WAIT(); __builtin_amdgcn_s_barrier(); asm volatile("" ::: "memory");
    }
#undef SW_LOAD
#undef SW_STORE
}

#define GEMM_PLAIN(Aptr, Btptr, Mv, Nv, Kv, Optr, ldcv, scalev, ACTv, rsv, csv) do { \
        pg8::Gemm g_{(const pg8::bf16_t*)(Aptr), (const pg8::bf16_t*)(Btptr), (Mv), (Nv), (Kv), 0, 0}; pg8::StaticOrder S_; S_.init((Mv), (Nv), F.G, (int)blockIdx.x); \
        pg8::EpiOut<ACTv, true> E_{(pg8::bf16_t*)(Optr), (ldcv), (scalev), 0x7fffffff, (rsv), (csv), 0, (LAS float*)(F.lds + RING_BYTES + 4096)}; \
        pg8::gemm_phase<pg8::EpiOut<ACTv, true>, pg8::StaticOrder, true, true>(F.lds + RING_OFF, g_, S_, E_); } while (0)

__global__ void __launch_bounds__(NWAVES * 64, 2) mk_fwd(Args args) {
    extern __shared__ __attribute__((aligned(16))) unsigned char lds[];
    Frame F;
    F.lds = (LAS unsigned char*)lds; F.tid = threadIdx.x; F.lane = F.tid & 63; F.wave = __builtin_amdgcn_readfirstlane(F.tid >> 6); F.G = gridDim.x;
    { const int bx = blockIdx.x; const int vcu = (F.G % 8 == 0) ? (bx % 8) * (F.G / 8) + bx / 8 : bx; F.grp = vcu >> 2; F.mem = vcu & 3; }
    volatile LAS unsigned* MISC = (volatile LAS unsigned*)(F.lds + MISC_OFF);
    for (int u = F.tid; u < (LDS_BYTES - LDSCTL_OFF) / 4; u += NWAVES * 64) ((LAS unsigned*)(F.lds + LDSCTL_OFF))[u] = 0u;
    __syncthreads();
    unsigned char* ws = args.ws;
    gu32* ctl = (gu32*)(ws + WS_CTL);
    XcdBarrier bar; bar.bar = (unsigned*)(ctl + CW_BAR); bar.x = 0; bar.st = nullptr;
    if (N_LAUNCHES == 1) bar = xcd_barrier_post((unsigned*)(ctl + CW_BAR), MISC + 8);
#define GRID_BAR() do { if (N_LAUNCHES == 1) xcd_barrier(bar); } while (0)
    unsigned gsync_k = 0;
#define GROUP_SYNC() do { if (N_LAUNCHES == 1) { gsync_k += 4u; asm volatile("s_waitcnt vmcnt(0)" ::: "memory"); __syncthreads(); \
        if (F.tid == 0) { gu32* c_ = ctl + CW_GRP + 64 * F.grp; __hip_atomic_fetch_add(c_, 1u, RLX_AGENT); unsigned sp_ = 0; \
            while (__hip_atomic_load(c_, RLX_AGENT) < gsync_k) { __builtin_amdgcn_s_sleep(1); if (++sp_ > (1u << 22)) { __hip_atomic_store(ctl + CW_TMO, 1u, RLX_AGENT); break; } } \
            __builtin_amdgcn_fence(__ATOMIC_ACQUIRE, "agent"); asm volatile("s_waitcnt vmcnt(0)" ::: "memory"); } \
        __syncthreads(); } } while (0)
#define GSEAM(k) do { if (IN(k) && IN((k) + 1)) GROUP_SYNC(); } while (0)
    const int lo = args.ph_lo, hi = args.ph_hi;
#define IN(k) (lo <= (k) && (k) < hi)
#define PHASE(k, ...) do { if (IN(k)) { __VA_ARGS__; if ((REPMASK >> (k)) & 1u) { __VA_ARGS__; } } } while (0)
#define SEAM(k) do { if (IN(k) && IN((k) + 1)) GRID_BAR(); } while (0)

    const float* x = (const float*)args.in[0];
    const float* g_mix_pre = (const float*)args.in[16]; const float* g_mix_post = (const float*)args.in[17]; const float* g_x_pre = (const float*)args.in[18]; const float* g_x_post = (const float*)args.in[19];
    const float* g_ff_pre = (const float*)args.in[24]; const float* g_ff_post = (const float*)args.in[25];
    bf16* WIN = (bf16*)(ws + WS_WIN); bf16* WOUT = (bf16*)(ws + WS_WOUT); bf16* WQKV = (bf16*)(ws + WS_WQKV); bf16* WSO = (bf16*)(ws + WS_WSO); bf16* WXQ = (bf16*)(ws + WS_WXQ);
    bf16* WXO = (bf16*)(ws + WS_WXO); bf16* WFF1 = (bf16*)(ws + WS_WFF1); bf16* WFF2 = (bf16*)(ws + WS_WFF2); bf16* RGW = (bf16*)(ws + WS_RGW); bf16* KV = (bf16*)(ws + WS_KV);
    float* ROPE = (float*)(ws + WS_ROPE); float* GIF = (float*)(ws + WS_GIF); float* NU = (float*)(ws + WS_NU); float* NPREV = (float*)(ws + WS_NPREV);
    float* ACH = (float*)(ws + WS_ACH); float* HCH = (float*)(ws + WS_HCH); float* HIN = (float*)(ws + WS_HIN);
    float* MLOC = (float*)(ws + WS_SCAL); float* BLAST = MLOC + 2048; float* MPREV = MLOC + 4096; float* SP = MLOC + 6144;
    bf16* R1 = (bf16*)(ws + WS_R1); bf16* R2 = (bf16*)(ws + WS_R2); bf16* R3 = (bf16*)(ws + WS_R3); bf16* HB = (bf16*)(ws + WS_R4); bf16* MBW = (bf16*)(ws + WS_MB); bf16* VWBW = (bf16*)(ws + WS_VWB); float* RS = (float*)(ws + WS_RS); bf16* YD = (bf16*)args.out; bf16* PD = (bf16*)args.out + 33554432;     bf16* CTB = (bf16*)args.out; unsigned* AUB = (unsigned*)args.out + 16777216;

    if (IN(0)) p0_prologue(F, args);
    SEAM(0);
    if (IN(1)) {
        if (blockIdx.x < 64) {
            pg8::Gemm g{(const pg8::bf16_t*)(ws + WS_AALL), (const pg8::bf16_t*)(ws + WS_BTALL), 2048, 4096, 1024, 0, 0}; pg8::DiagOrder S{(int)blockIdx.x};
            pg8::EpiOut<0> E{(pg8::bf16_t*)KV, 2048, 1.0f, 7, nullptr, nullptr, 0};
            pg8::gemm_phase<pg8::EpiOut<0>, pg8::DiagOrder, true, true>(F.lds + RING_OFF, g, S, E);
        } else {
            norm_phase<0, true>(F, nullptr, nullptr, x, HB, RS, nullptr, g_mix_pre, 64, (const float*)args.in[3], (const float*)args.in[4], GIF);
        }
    }
    SEAM(1);
    PHASE(2, { const int kind = (int)blockIdx.x >> 7, c_ = (int)blockIdx.x & 127, q_ = c_ & 3, h_ = (c_ >> 2) & 3, b_ = (c_ >> 4) & 3, l_ = c_ >> 6;
               const bf16* kvp = KV + (size_t)(l_ * 1024 + b_ * 256) * 2048 + h_ * 256; const bf16* wqp = WXQ + (size_t)l_ * 1048576 + (size_t)q_ * 262144 + h_ * 256; const bf16* wop = WXO + (size_t)l_ * 1048576 + (size_t)q_ * 262144 + h_ * 256;
               pg8::Gemm g{(const pg8::bf16_t*)(kind == 0 ? kvp : wop), (const pg8::bf16_t*)(kind == 0 ? wqp : kvp + 1024), 256, 256, 256, kind == 0 ? 2048 : 1024, kind == 0 ? 1024 : 2048}; pg8::OneUnit S;
               pg8::EpiFold E{(pg8::bf16_t*)((kind == 0 ? MBW : VWBW) + (size_t)(l_ * 4 + b_) * 1048576 + (kind == 0 ? (size_t)(h_ * 256) * 1024 + q_ * 256 : (size_t)(q_ * 256) * 1024 + h_ * 256))};
               if (blockIdx.x < 256) pg8::gemm_phase<pg8::EpiFold, pg8::OneUnit, true, true>(F.lds + RING_OFF, g, S, E); }
        GEMM_PLAIN(HB, WIN + (size_t)512 * 1024, T_, ZC_, 1024, R2, ZC_, 1.0f, 0, RS, nullptr); GEMM_PLAIN(WIN, HB, 512, T_, 1024, R3, T_, 1.0f, 0, nullptr, RS));
    SEAM(2);
    PHASE(3, mlstm_A(F, R2, R3, GIF, R1, NU, MLOC, BLAST); LDS_WAIT(); __builtin_amdgcn_s_barrier(); asm volatile("" ::: "memory");
        rg_A(F, R2, (const float*)args.in[5], (const float*)args.in[6], RGW, (const float*)args.in[8], (const float*)args.in[10], SP, ACH, HCH, AUB); __syncthreads());
    SEAM(3);
    PHASE(4, mlstm_B(F, R1, NU, MLOC, BLAST, CTB, NPREV, MPREV); rg_B(F, ACH, HCH, HIN));
    SEAM(4);
    PHASE(5, mlstm_C(F, R2, R3, GIF, CTB, NPREV, MPREV, R1); rg_C(F, R2, AUB, HIN, R1));
    SEAM(5);
#define GEMM_GROUP(Aptr, ldav, Btptr, Kv, Optr, ldcv, perv, batchedv, ACTv, rsv) do { \
        pg8::Gemm g_{(const pg8::bf16_t*)(Aptr), (const pg8::bf16_t*)(Btptr), T_, 1024 * (perv), (Kv), (ldav), 0}; pg8::GroupOrder S_{F.grp, F.mem, (perv), (batchedv)}; \
        pg8::EpiOut<ACTv, (ACTv) == 2> E_{(pg8::bf16_t*)(Optr), (ldcv), 1.0f, 0x7fffffff, (rsv), nullptr, 1, (LAS float*)(F.lds + RING_BYTES + 4096)}; \
        pg8::gemm_phase<pg8::EpiOut<ACTv, (ACTv) == 2>, pg8::GroupOrder, true, true>(F.lds + RING_OFF, g_, S_, E_); } while (0)
    PHASE(6, GEMM_GROUP(R1, 0, WOUT, 1024, YD, 1024, 1, 0, 0, nullptr));
    GSEAM(6);
    if (IN(7)) norm_phase<1, false, true>(F, YD, g_mix_post, HB, HB, RS, nullptr, nullptr, 0, nullptr, nullptr, nullptr, 1024);
    GSEAM(7);
#define SHARED_PART(L, base) do { \
    PHASE((base) + 0, { pg8::Gemm g{(const pg8::bf16_t*)HB, (const pg8::bf16_t*)(MBW + (size_t)(L) * 4194304), T_, 1024, 1024, 0, 0}; pg8::GroupOrder S{F.grp, F.mem, 1, 1}; \
        pg8::EpiSoftmax E{(pg8::bf16_t*)PD, 1024, RS, 0.0625f * 1.4426950408889634f, (LAS float*)(F.lds + RING_BYTES)}; \
        pg8::gemm_phase<pg8::EpiSoftmax, pg8::GroupOrder, true, true>(F.lds + RING_OFF, g, S, E); }); \
    GSEAM((base) + 0); \
    PHASE((base) + 1, GEMM_GROUP(PD, 0, VWBW + (size_t)(L) * 4194304, 1024, YD, 1024, 1, 1, 0, nullptr)); \
    GSEAM((base) + 1); \
    if (IN((base) + 2)) norm_phase<1, false, true>(F, YD, g_x_post + (L) * 1024, HB, HB, RS, nullptr, nullptr, 0, nullptr, nullptr, nullptr, 1024); \
    GSEAM((base) + 2); \
    PHASE((base) + 3, GEMM_GROUP(HB, 0, WFF1 + (size_t)(L) * 4194304, 1024, R2, FF_, 4, 0, 2, RS)); \
    GSEAM((base) + 3); \
    PHASE((base) + 4, GEMM_GROUP(R2, 0, WFF2 + (size_t)(L) * 4194304, FF_, ((L) == 1 ? R1 : YD), 1024, 1, 0, 0, nullptr)); \
    if ((L) == 1) SEAM((base) + 4); else GSEAM((base) + 4); } while (0)
    SHARED_PART(0, 8);
    if (IN(13)) norm_phase<1, false, true>(F, YD, g_ff_post, HB, HB, RS, nullptr, nullptr, 0, nullptr, nullptr, nullptr, 1024);
    SEAM(13);
    PHASE(14, { pg8::Gemm g{(const pg8::bf16_t*)HB, (const pg8::bf16_t*)WQKV, T_, QKC_, 1024, 0, 0}; pg8::StaticOrder S; S.init(T_, QKC_, F.G, (int)blockIdx.x);
          pg8::EpiRope E{(pg8::bf16_t*)R2, QKC_, ROPE, 1024, 0.125f * 1.4426950408889634f, RS};
          pg8::gemm_phase<pg8::EpiRope, pg8::StaticOrder, true, true>(F.lds + RING_OFF, g, S, E); });
    SEAM(14);
    PHASE(15, swa_phase(F, R2, R3, (const float*)args.in[14], R1));
    SEAM(15);
    PHASE(16, GEMM_GROUP(R1, 0, WSO, 1024, YD, 1024, 1, 0, 0, nullptr));
    GSEAM(16);
    if (IN(17)) norm_phase<1, false, true>(F, YD, g_mix_post + 1024, HB, HB, RS, nullptr, nullptr, 0, nullptr, nullptr, nullptr, 1024);
    GSEAM(17);
    SHARED_PART(1, 18);
    if (IN(23)) norm_phase<2, false, true>(F, R1, g_ff_post + 1024, HB, nullptr, nullptr, args.out, nullptr, 0, nullptr, nullptr, nullptr, 1024);
#if RUN_PHASES < 8
    if (lo == RUN_PHASES) { for (size_t i = (size_t)blockIdx.x * 512 + F.tid; i < (size_t)T_ * D_ / 4; i += (size_t)F.G * 512) {
        f32x4 o_;
        if (DBG_F32) { o_ = (i < (size_t)DBG_F32 / 4) ? ((const f32x4*)(ws + DBG_SRC))[i] : (f32x4){0.f, 0.f, 0.f, 0.f}; }
        else { const v2u w_ = ((const v2u*)(ws + DBG_SRC))[i]; o_ = (f32x4){bflo(w_.x), bfhi(w_.x), bflo(w_.y), bfhi(w_.y)}; }
        if (DBG_SAN) { for (int e_ = 0; e_ < 4; ++e_) if (!(fabsf(o_[e_]) < 1e30f)) o_[e_] = 777.f; }
        ((f32x4*)args.out)[i] = o_; } }
#endif
#undef IN
#undef SEAM
}

extern "C" void kernel_launch(void* const* d_in, const int* in_sizes, int n_in, void* d_out, int out_size, void* d_ws, size_t ws_size, hipStream_t stream) {
    static int grid = 0;
    if (grid == 0) {
        if (n_in != 28 || in_sizes[0] != T_ * D_ || out_size != T_ * D_ || ws_size < WS_END) { fprintf(stderr, "kernel_launch: unexpected shapes: n_in %d in0 %d out %d ws %zu (need %zu)\n", n_in, n_in > 0 ? in_sizes[0] : -1, out_size, ws_size, (size_t)WS_END); grid = -1; return; }
        int dev = 0, cus = 0, per_cu = 0;
        if (hipGetDevice(&dev) != hipSuccess || hipDeviceGetAttribute(&cus, hipDeviceAttributeMultiprocessorCount, dev) != hipSuccess) { grid = -1; return; }
        if (hipFuncSetAttribute((const void*)mk_fwd, hipFuncAttributeMaxDynamicSharedMemorySize, LDS_BYTES) != hipSuccess) { fprintf(stderr, "kernel_launch: hipFuncSetAttribute failed\n"); grid = -1; return; }
        if (hipOccupancyMaxActiveBlocksPerMultiprocessor(&per_cu, (const void*)mk_fwd, NWAVES * 64, LDS_BYTES) != hipSuccess || per_cu < 1) fprintf(stderr, "kernel_launch: occupancy query reports %d\n", per_cu);
        (void)hipGetLastError();
        grid = cus;
        if (grid < 128) { fprintf(stderr, "kernel_launch: %d CUs: too few\n", grid); grid = -1; return; }
    }
    if (grid < 0) return;
    if (hipMemsetAsync((char*)d_ws + WS_CTL, 0, CTL_ZERO_BYTES, stream) != hipSuccess) return;
    Args a{};
    for (int i = 0; i < 28; ++i) a.in[i] = d_in[i];
    a.out = (float*)d_out; a.ws = (unsigned char*)d_ws;
    for (int li = 0; li < (N_LAUNCHES == 1 ? 1 : RUN_PHASES + (RUN_PHASES < 8 ? 1 : 0)); ++li) {
        if (N_LAUNCHES == 1) { a.ph_lo = 0; a.ph_hi = RUN_PHASES; } else { a.ph_lo = li; a.ph_hi = (li == RUN_PHASES) ? li : li + 1; }
        hipLaunchKernelGGL(mk_fwd, dim3(grid), dim3(NWAVES * 64), LDS_BYTES, stream, a);
        const hipError_t le = hipPeekAtLastError();
        if (le != hipSuccess) { fprintf(stderr, "kernel_launch: launch %d failed: %s\n", li, hipGetErrorName(le)); break; }
    }
}
```
